# Optimizing an MI355X kernel written in HIP

```python
import jax, jax.numpy as jnp
from jax import lax
import numpy as np

D_MODEL = 1024
BATCH = 8
SEQ = 2048
DEPTH = 1
DEC_BATCH = 128
DEC_SEQ = 8
PAST_LEN = 2048
PAGE_SIZE = 128

HG_HEADS = 4
HG_DK = 128
HG_DV = 128
HG_KW = HG_HEADS * HG_DK
HG_WIDTH = HG_HEADS * HG_DV
HG_CHUNK = 32
FOX_HEADS = 8
FOX_DH = 64
FOX_WIDTH = FOX_HEADS * FOX_DH
Q_BLOCK = 128
D_FF = 4 * D_MODEL
N_BRANCH = 2
N_MOD = 6
RMS_EPS = 1e-6
SPLIT_SIZES = (HG_KW, HG_KW, HG_WIDTH, HG_WIDTH, FOX_WIDTH, FOX_WIDTH, FOX_WIDTH, FOX_HEADS, N_BRANCH * D_MODEL)
IN_COLS = sum(SPLIT_SIZES)
SPLIT_IDX = [int(i) for i in np.cumsum(SPLIT_SIZES)[:-1]]

kernel_name = "hybrid_hgrn2_fox_adaln_step"


def rmsnorm(x, w):
    x32 = x.astype(jnp.float32)
    r = x32 * lax.rsqrt(jnp.mean(x32 * x32, axis=-1, keepdims=True) + RMS_EPS)
    return (r * w.astype(jnp.float32)).astype(x.dtype)


def hgrn_chunked(q, k, v, logf, s0):
    B, L, H, DK = q.shape
    DV = v.shape[-1]
    C = HG_CHUNK if L % HG_CHUNK == 0 else L
    n = L // C

    def to_chunks(a):
        return jnp.moveaxis(a.astype(jnp.float32).reshape(B, n, C, H, a.shape[-1]), 1, 0)

    causal = jnp.tril(jnp.ones((C, C), dtype=bool))

    def step(S, inp):
        qc, kc, vc, gc = inp
        b = jnp.cumsum(gc, axis=1)
        qt = qc * jnp.exp(b)
        kt = kc * jnp.exp(-b)
        a = jnp.where(causal, jnp.einsum('bthk,bshk->bhts', qt, kt), 0.0)
        o = jnp.einsum('bchk,bhkv->bchv', qt, S) + jnp.einsum('bhts,bshv->bthv', a, vc)
        bl = b[:, -1:]
        S = jnp.exp(bl[:, 0])[..., None] * S + jnp.einsum('bshk,bshv->bhkv', kc * jnp.exp(bl - b), vc)
        return S, o

    S, o = lax.scan(step, s0.astype(jnp.float32), (to_chunks(q), to_chunks(k), to_chunks(v), to_chunks(logf)))
    o = jnp.moveaxis(o, 0, 1).reshape(B, L, H, DV)
    return o.astype(v.dtype), S.astype(s0.dtype)


def fox_attend(q, k, v, dq, dk, q_pos, k_pos):
    B, Lq, H, Dh = q.shape
    bq = Q_BLOCK if Lq % Q_BLOCK == 0 else Lq
    nb = Lq // bq
    scale = Dh ** -0.5
    qs = jnp.moveaxis(q.reshape(B, nb, bq, H, Dh), 1, 0)
    dqs = jnp.moveaxis(dq.reshape(B, nb, bq, H), 1, 0)
    qps = q_pos.reshape(nb, bq)
    dk_t = jnp.transpose(dk, (0, 2, 1))[:, :, None, :]

    def blk(args):
        qb, dqb, qpb = args
        s = jnp.einsum('bqhd,bkhd->bhqk', qb, k, preferred_element_type=jnp.float32) * scale
        s = s + jnp.transpose(dqb, (0, 2, 1))[..., None] - dk_t
        mask = k_pos[None, :] <= qpb[:, None]
        s = jnp.where(mask, s, -jnp.inf)
        p = jax.nn.softmax(s, axis=-1)
        return jnp.einsum('bhqk,bkhd->bqhd', p.astype(v.dtype), v)

    o = lax.map(blk, (qs, dqs, qps))
    return jnp.moveaxis(o, 0, 1).reshape(B, Lq, H, Dh)


def token_mixer(h, lw, lb, s0, past):
    B, L, _ = h.shape
    hq, hf, hi, hg, fq, fk, fv, ff, mg = jnp.split(h @ lw['w_in'], SPLIT_IDX, axis=-1)
    hf32 = hf.astype(jnp.float32)
    f = lb + (1.0 - lb) * jax.nn.sigmoid(hf32)
    g_log = jnp.log(f)
    k_in = (1.0 - lb) * jax.nn.sigmoid(-hf32)
    q_h = hq.reshape(B, L, HG_HEADS, HG_DK) * (HG_DK ** -0.5)
    o_h, s_new = hgrn_chunked(q_h, k_in.reshape(B, L, HG_HEADS, HG_DK),
                              hi.reshape(B, L, HG_HEADS, HG_DV),
                              g_log.reshape(B, L, HG_HEADS, HG_DK), s0)
    o_h = rmsnorm(o_h, lw['hg_onorm']) * jax.nn.silu(hg.reshape(B, L, HG_HEADS, HG_DV))
    br_h = o_h.reshape(B, L, HG_WIDTH) @ lw['w_br_h']
    q_f = fq.reshape(B, L, FOX_HEADS, FOX_DH)
    k_f = fk.reshape(B, L, FOX_HEADS, FOX_DH)
    v_f = fv.reshape(B, L, FOX_HEADS, FOX_DH)
    logf = jax.nn.log_sigmoid(ff.astype(jnp.float32) + lw['fox_b_f'].astype(jnp.float32))
    if past is None:
        kk, vv, lf_all = k_f, v_f, logf
    else:
        pk, pv, plf = past
        kk = jnp.concatenate([pk, k_f], axis=1)
        vv = jnp.concatenate([pv, v_f], axis=1)
        lf_all = jnp.concatenate([plf.astype(jnp.float32), logf], axis=1)
    Lk = kk.shape[1]
    D = jnp.cumsum(lf_all, axis=1)
    k_pos = jnp.arange(Lk, dtype=jnp.int32)
    q_pos = k_pos[Lk - L:]
    o_f = fox_attend(q_f, kk, vv, D[:, Lk - L:], D, q_pos, k_pos)
    br_f = o_f.reshape(B, L, FOX_WIDTH) @ lw['w_br_f']
    g_h, g_f = jnp.split(jax.nn.sigmoid(mg), N_BRANCH, axis=-1)
    y = (g_h * br_h + g_f * br_f) @ lw['w_out']
    return y, (k_f, v_f, logf.astype(h.dtype), s_new)


def layer(x, c, lw, lb, s0, past):
    mod = (jax.nn.silu(c) @ lw['ada_w'] + lw['ada_b'])[:, None, :]
    sh1, sc1, gt1, sh2, sc2, gt2 = jnp.split(mod, N_MOD, axis=-1)
    h = rmsnorm(x, lw['n1_pre']) * (1.0 + sc1) + sh1
    y, new_state = token_mixer(h, lw, lb, s0, past)
    x = x + gt1 * rmsnorm(y, lw['n1_post'])
    h = rmsnorm(x, lw['n2_pre']) * (1.0 + sc2) + sh2
    u = jnp.square(jax.nn.relu(h @ lw['w_up'])) @ lw['w_down']
    x = x + gt2 * rmsnorm(u, lw['n2_post'])
    return x, new_state


def setup_inputs(seed: int = 0) -> dict:
    key = jax.random.key(seed)
    ks = jax.random.split(key, 32)
    f32 = jnp.float32

    def nrm(k, shape, scale):
        return jax.random.normal(k, shape, f32) * scale

    n_pages = PAST_LEN // PAGE_SIZE
    n_used = DEC_BATCH * n_pages
    n_phys = n_used + max(1, n_used // 4)
    page_table = jax.random.permutation(ks[0], n_phys)[:n_used].reshape(DEC_BATCH, n_pages).astype(jnp.int32)
    return {
        'x_prompt': nrm(ks[1], (BATCH, SEQ, D_MODEL), 1.0),
        'x_sample': nrm(ks[2], (DEC_BATCH, DEC_SEQ, D_MODEL), 1.0),
        'c_prompt': nrm(ks[3], (BATCH, D_MODEL), 1.0),
        'c_sample': nrm(ks[4], (DEC_BATCH, D_MODEL), 1.0),
        'cache_k': nrm(ks[5], (DEPTH, n_phys, PAGE_SIZE, FOX_HEADS, FOX_DH), 1.0),
        'cache_v': nrm(ks[6], (DEPTH, n_phys, PAGE_SIZE, FOX_HEADS, FOX_DH), 1.0),
        'cache_logf': jax.nn.log_sigmoid(2.0 + nrm(ks[7], (DEPTH, n_phys, PAGE_SIZE, FOX_HEADS), 1.0)),
        'state_hgrn': nrm(ks[8], (DEPTH, DEC_BATCH, HG_HEADS, HG_DK, HG_DV), 0.5),
        'page_table': page_table,
        'ada_w': nrm(ks[9], (DEPTH, D_MODEL, N_MOD * D_MODEL), 0.5 * D_MODEL ** -0.5),
        'ada_b': nrm(ks[10], (DEPTH, N_MOD * D_MODEL), 0.02),
        'norm_mix_pre': 1.0 + nrm(ks[11], (DEPTH, D_MODEL), 0.02),
        'norm_mix_post': 1.0 + nrm(ks[12], (DEPTH, D_MODEL), 0.02),
        'norm_mlp_pre': 1.0 + nrm(ks[13], (DEPTH, D_MODEL), 0.02),
        'norm_mlp_post': 1.0 + nrm(ks[14], (DEPTH, D_MODEL), 0.02),
        'w_in': nrm(ks[15], (DEPTH, D_MODEL, IN_COLS), D_MODEL ** -0.5),
        'hgrn_lower_bounds': nrm(ks[16], (DEPTH + 1, HG_KW), 0.1),
        'hgrn_onorm': 1.0 + nrm(ks[17], (DEPTH, HG_DV), 0.02),
        'fox_b_f': 2.0 + nrm(ks[18], (DEPTH, FOX_HEADS), 0.1),
        'w_br_h': nrm(ks[19], (DEPTH, HG_WIDTH, D_MODEL), HG_WIDTH ** -0.5),
        'w_br_f': nrm(ks[20], (DEPTH, FOX_WIDTH, D_MODEL), FOX_WIDTH ** -0.5),
        'w_out': nrm(ks[21], (DEPTH, D_MODEL, D_MODEL), D_MODEL ** -0.5),
        'w_mlp_up': nrm(ks[22], (DEPTH, D_MODEL, D_FF), D_MODEL ** -0.5),
        'w_mlp_down': nrm(ks[23], (DEPTH, D_FF, D_MODEL), D_FF ** -0.5),
    }


def reference(x_prompt, x_sample, c_prompt, c_sample, cache_k, cache_v, cache_logf, state_hgrn, page_table,
              ada_w, ada_b, norm_mix_pre, norm_mix_post, norm_mlp_pre, norm_mlp_post, w_in,
              hgrn_lower_bounds, hgrn_onorm, fox_b_f, w_br_h, w_br_f, w_out, w_mlp_up, w_mlp_down):
    lb_all = jnp.cumsum(jax.nn.softmax(hgrn_lower_bounds.astype(jnp.float32), axis=0), axis=0)
    n_dec, n_pages = page_table.shape
    yp, ys = x_prompt, x_sample
    kp_l, vp_l, lfp_l, sp_l, ks_l, vs_l, lfs_l, ss_l = [], [], [], [], [], [], [], []
    for l in range(DEPTH):
        lw = {'ada_w': ada_w[l], 'ada_b': ada_b[l], 'n1_pre': norm_mix_pre[l], 'n1_post': norm_mix_post[l],
              'n2_pre': norm_mlp_pre[l], 'n2_post': norm_mlp_post[l], 'w_in': w_in[l],
              'hg_onorm': hgrn_onorm[l], 'fox_b_f': fox_b_f[l], 'w_br_h': w_br_h[l], 'w_br_f': w_br_f[l],
              'w_out': w_out[l], 'w_up': w_mlp_up[l], 'w_down': w_mlp_down[l]}
        lb = lb_all[l]
        s0 = jnp.zeros((x_prompt.shape[0], HG_HEADS, HG_DK, HG_DV), x_prompt.dtype)
        yp, (kp, vp, lfp, sp) = layer(yp, c_prompt, lw, lb, s0, None)
        past_k = cache_k[l][page_table].reshape(n_dec, n_pages * PAGE_SIZE, FOX_HEADS, FOX_DH)
        past_v = cache_v[l][page_table].reshape(n_dec, n_pages * PAGE_SIZE, FOX_HEADS, FOX_DH)
        past_lf = cache_logf[l][page_table].reshape(n_dec, n_pages * PAGE_SIZE, FOX_HEADS)
        ys, (kss, vss, lfs, ss) = layer(ys, c_sample, lw, lb, state_hgrn[l], (past_k, past_v, past_lf))
        kp_l.append(kp); vp_l.append(vp); lfp_l.append(lfp); sp_l.append(sp)
        ks_l.append(kss); vs_l.append(vss); lfs_l.append(lfs); ss_l.append(ss)
    k_prompt = jnp.stack(kp_l)
    v_prompt = jnp.stack(vp_l)
    logf_prompt = jnp.stack(lfp_l)
    s_prompt = jnp.stack(sp_l)
    k_sample = jnp.stack(ks_l)
    v_sample = jnp.stack(vs_l)
    logf_sample = jnp.stack(lfs_l)
    s_sample = jnp.stack(ss_l)
    return (yp, ys, k_prompt, v_prompt, logf_prompt, s_prompt, k_sample, v_sample, logf_sample, s_sample)
```

```cpp
#include <hip/hip_runtime.h>
#include <cstdio>
#include <cstdint>
namespace pg8 {
#define PG8_LAS __attribute__((address_space(3)))
typedef unsigned short bf16_t;
typedef short bf16x8 __attribute__((ext_vector_type(8)));
typedef float f32x4 __attribute__((ext_vector_type(4)));
typedef unsigned u32x4 __attribute__((ext_vector_type(4)));
constexpr int BM = 256, BK = 64, HALF = 128, HTB = HALF * BK * 2  , STAGE_BYTES = 8 * HTB, NXCD = 8, WGM = 8;

__host__ __device__ __forceinline__ int lds_byte(int r, int c) { const int st = (r >> 4) * 2 + (c >> 5), rr = r & 15, cc = c & 31, ob = rr * 64 + cc * 2; return st * 1024 + (ob ^ (((ob >> 9) & 1) << 5)); }
__host__ __device__ __forceinline__ void stage_rc(int b, int& R, int& C) { const int st = b / 1024, sb = b % 1024, swz = sb ^ (((sb >> 9) & 1) << 5); R = (st >> 1) * 16 + swz / 64; C = (st & 1) * 32 + (swz % 64) / 2; }
__host__ __device__ __forceinline__ int perm32(int rho) { const int n = rho >> 4, i = rho & 15; return 8 * (i >> 2) + 4 * n + (i & 3); }

struct Unit { int pm, pn; };
struct Gemm { const bf16_t* A; const bf16_t* Bt; int M, N, K; };

struct StaticOrder {
    int nM, nN, nwg, G, c;
    __host__ __device__ void init(int M, int N, int G_, int c_) { nM = M / BM; nN = N / BM; nwg = nM * nN; G = G_; c = c_; }
    __host__ __device__ bool next(int i, Unit& u) const {
        const long L = (long)i * G + c; if (L >= nwg) return false;
        int wgid = (int)L; { const int q = nwg / NXCD, r = nwg % NXCD, xcd = wgid % NXCD, off = wgid / NXCD; wgid = (xcd < r ? xcd * (q + 1) : r * (q + 1) + (xcd - r) * q) + off; }
        const int nig = WGM * nN, gid = wgid / nig, fm = gid * WGM, gsz = (nM - fm) < WGM ? (nM - fm) : WGM;
        u.pm = fm + ((wgid % nig) % gsz); u.pn = (wgid % nig) / gsz; return true;
    }
    __device__ __forceinline__ void a_ready(const Unit&) const {}
    __device__ __forceinline__ void done(const Unit&) const {}
};

__device__ __forceinline__ unsigned cvt_pk_bf16(float lo, float hi) { unsigned r; asm volatile("v_cvt_pk_bf16_f32 %0, %1, %2" : "=v"(r) : "v"(lo), "v"(hi)); return r; }
typedef float f32x2 __attribute__((ext_vector_type(2)));
template <class Epi, class Sched, bool ALIGN_EPI = false, bool SP2 = false>
__device__ __forceinline__ void gemm_phase(PG8_LAS unsigned char* lds, const Gemm g, const Sched& S, const Epi& E) {
    const int tid = threadIdx.x, wid = __builtin_amdgcn_readfirstlane(tid >> 6), lane = tid & 63, wr = wid >> 2, wc = wid & 3, fr = lane & 15, fq = lane >> 4;
    const int K = g.K, nt = K / BK;
    unsigned voffA[2], voffB[2];
#pragma unroll
    for (int i = 0; i < 2; ++i) { int R, C; stage_rc(tid * 16 + i * 8192, R, C); const int Rb = Epi::PERM ? ((R & ~31) + perm32(R & 31)) : R;
        voffA[i] = (unsigned)(R * K + C) * 2u; voffB[i] = (unsigned)(Rb * K + C) * 2u; }
    const size_t kstep = (size_t)(BK * 2);
    const size_t hstep = (size_t)HALF * K * 2;
    const size_t tstep = 2 * hstep;
    const unsigned ldsw = (unsigned)wid * 1024u;
    const int aoff = lds_byte(wr * 64 + fr, fq * 8), boff = lds_byte(wc * 32 + fr, fq * 8);
#define PG8_SA(b, h) (((b) * 2 + (h)) * HTB)
#define PG8_SB(b, h) ((4 + (b) * 2 + (h)) * HTB)
#define PG8_STAGE(bufoff, gbase, voff) do { _Pragma("unroll") for (int _i = 0; _i < 2; ++_i) \
        __builtin_amdgcn_global_load_lds((const unsigned*)((const char*)(gbase) + (voff)[_i]), (PG8_LAS unsigned*)(lds + (bufoff) + ldsw + _i * 8192), 16, 0, 0); } while (0)
#define PG8_LDA(dst, b, h) do { _Pragma("unroll") for (int m = 0; m < 4; ++m) _Pragma("unroll") for (int k = 0; k < 2; ++k) dst[m][k] = *(const PG8_LAS bf16x8*)(lds + PG8_SA(b, h) + aoff + m * 2048 + k * 1024); } while (0)
#define PG8_LDB(dst, b, h) do { _Pragma("unroll") for (int n = 0; n < 2; ++n) _Pragma("unroll") for (int k = 0; k < 2; ++k) dst[n][k] = *(const PG8_LAS bf16x8*)(lds + PG8_SB(b, h) + boff + n * 2048 + k * 1024); } while (0)
#define PG8_MMA(ai, bj, At, Bt) do { __builtin_amdgcn_s_setprio(1); _Pragma("unroll") for (int m = 0; m < 4; ++m) _Pragma("unroll") for (int n = 0; n < 2; ++n) _Pragma("unroll") for (int k = 0; k < 2; ++k) \
        acc[ai][bj][m][n] = __builtin_amdgcn_mfma_f32_16x16x32_bf16(Bt[n][k], At[m][k], acc[ai][bj][m][n], 0, 0, 0); __builtin_amdgcn_s_setprio(0); } while (0)
#define PG8_WAIT_V(n) asm volatile("s_waitcnt vmcnt(" #n ")" ::: "memory")
#define PG8_WAIT_L(n) asm volatile("s_waitcnt lgkmcnt(" #n ")" ::: "memory")
#define PG8_BAR __builtin_amdgcn_s_barrier()
#define PG8_SCHED __builtin_amdgcn_sched_barrier(0)
    Unit cur, nxt; int ui = 0;
    if (!S.next(0, cur)) return;
    f32x4 acc[2][2][4][2];
#pragma unroll
    for (int a = 0; a < 2; ++a)
#pragma unroll
        for (int b = 0; b < 2; ++b)
#pragma unroll
            for (int m = 0; m < 4; ++m)
#pragma unroll
                for (int n = 0; n < 2; ++n) acc[a][b][m][n] = (f32x4){0.f, 0.f, 0.f, 0.f};
    bf16x8 At[4][2], B0[2][2], B1[2][2];
    const char* cA = (const char*)g.A + (size_t)cur.pm * tstep; const char* cB = (const char*)g.Bt + (size_t)cur.pn * tstep;
    S.a_ready(cur);
    if constexpr (SP2) {
        PG8_STAGE(PG8_SB(0, 0), cB, voffB); PG8_STAGE(PG8_SB(0, 1), cB + hstep, voffB); PG8_STAGE(PG8_SA(0, 0), cA, voffA); PG8_STAGE(PG8_SA(0, 1), cA + hstep, voffA);
        if (wr == 1) PG8_BAR;
        PG8_WAIT_V(2); PG8_BAR;
        PG8_STAGE(PG8_SB(1, 0), cB + kstep, voffB); PG8_STAGE(PG8_SA(1, 0), cA + kstep, voffA); PG8_STAGE(PG8_SB(1, 1), cB + hstep + kstep, voffB);
        PG8_WAIT_V(6); PG8_BAR;
    } else {
        PG8_STAGE(PG8_SB(0, 0), cB, voffB); PG8_STAGE(PG8_SA(0, 0), cA, voffA); PG8_STAGE(PG8_SB(0, 1), cB + hstep, voffB); PG8_STAGE(PG8_SA(0, 1), cA + hstep, voffA);
        if (wr == 1) PG8_BAR;
        PG8_WAIT_V(4); PG8_BAR;
        PG8_STAGE(PG8_SB(1, 0), cB + kstep, voffB); PG8_STAGE(PG8_SA(1, 0), cA + kstep, voffA); PG8_STAGE(PG8_SB(1, 1), cB + hstep + kstep, voffB);
        PG8_WAIT_V(6); PG8_BAR;
    }
    for (;;) {
        const bool has_next = S.next(ui + 1, nxt);
        const char* nA = has_next ? (const char*)g.A + (size_t)nxt.pm * tstep : cA; const char* nB = has_next ? (const char*)g.Bt + (size_t)nxt.pn * tstep : cB;
        for (int t = 0; t < nt; t += 2) {
            const bool last = (t == nt - 2);
            const char* a1 = cA + (size_t)(t + 1) * kstep;
            const char* a2 = last ? nA : cA + (size_t)(t + 2) * kstep; const char* b2 = last ? nB : cB + (size_t)(t + 2) * kstep;
            const char* a3 = a2 + kstep; const char* b3 = b2 + kstep;
            if (last && has_next) S.a_ready(nxt);
            if constexpr (SP2) {
            PG8_LDB(B0, 0, 0); PG8_LDB(B1, 0, 1); PG8_SCHED; PG8_LDA(At, 0, 0); PG8_STAGE(PG8_SA(1, 1), a1 + hstep, voffA);
            PG8_WAIT_V(8); PG8_WAIT_L(0); PG8_BAR; PG8_MMA(0, 0, At, B0); PG8_MMA(0, 1, At, B1); PG8_BAR; PG8_SCHED;
            PG8_LDA(At, 0, 1); PG8_STAGE(PG8_SB(0, 0), b2, voffB); PG8_STAGE(PG8_SB(0, 1), b2 + hstep, voffB); PG8_STAGE(PG8_SA(0, 0), a2, voffA);
            PG8_WAIT_V(8); PG8_WAIT_L(0); PG8_BAR; PG8_MMA(1, 0, At, B0); PG8_MMA(1, 1, At, B1); PG8_BAR; PG8_SCHED;
            PG8_LDB(B0, 1, 0); PG8_LDB(B1, 1, 1); PG8_SCHED; PG8_LDA(At, 1, 0); PG8_STAGE(PG8_SA(0, 1), a2 + hstep, voffA);
            PG8_WAIT_V(8); PG8_WAIT_L(0); PG8_BAR; PG8_MMA(0, 0, At, B0); PG8_MMA(0, 1, At, B1); PG8_BAR; PG8_SCHED;
            PG8_LDA(At, 1, 1); PG8_STAGE(PG8_SB(1, 0), b3, voffB); PG8_STAGE(PG8_SB(1, 1), b3 + hstep, voffB); PG8_STAGE(PG8_SA(1, 0), a3, voffA);
            PG8_WAIT_V(8); PG8_WAIT_L(0); PG8_BAR; PG8_MMA(1, 0, At, B0); PG8_MMA(1, 1, At, B1); PG8_BAR; PG8_SCHED;
            } else {
            PG8_LDB(B0, 0, 0); PG8_SCHED; PG8_LDA(At, 0, 0); PG8_STAGE(PG8_SA(1, 1), a1 + hstep, voffA);
            PG8_WAIT_L(8); PG8_BAR; PG8_WAIT_L(0); PG8_MMA(0, 0, At, B0); PG8_BAR; PG8_SCHED;
            PG8_LDB(B1, 0, 1); PG8_STAGE(PG8_SB(0, 0), b2, voffB);
            PG8_BAR; PG8_WAIT_L(0); PG8_MMA(0, 1, At, B1); PG8_BAR;
            PG8_LDA(At, 0, 1); PG8_STAGE(PG8_SA(0, 0), a2, voffA);
            PG8_BAR; PG8_WAIT_L(0); PG8_MMA(1, 0, At, B0); PG8_BAR; PG8_SCHED;
            PG8_STAGE(PG8_SB(0, 1), b2 + hstep, voffB);
            PG8_WAIT_V(6); PG8_BAR; PG8_MMA(1, 1, At, B1); PG8_BAR;
            PG8_LDB(B0, 1, 0); PG8_SCHED; PG8_LDA(At, 1, 0); PG8_STAGE(PG8_SA(0, 1), a2 + hstep, voffA);
            PG8_WAIT_L(8); PG8_BAR; PG8_WAIT_L(0); PG8_MMA(0, 0, At, B0); PG8_BAR; PG8_SCHED;
            PG8_LDB(B1, 1, 1); PG8_STAGE(PG8_SB(1, 0), b3, voffB);
            PG8_BAR; PG8_WAIT_L(0); PG8_MMA(0, 1, At, B1); PG8_BAR;
            PG8_LDA(At, 1, 1); PG8_STAGE(PG8_SA(1, 0), a3, voffA);
            PG8_BAR; PG8_WAIT_L(0); PG8_MMA(1, 0, At, B0); PG8_BAR; PG8_SCHED;
            PG8_STAGE(PG8_SB(1, 1), b3 + hstep, voffB);
            PG8_WAIT_V(6); PG8_BAR; PG8_MMA(1, 1, At, B1); PG8_BAR;
            }
        }
        if constexpr (ALIGN_EPI) { if (wr == 0) PG8_BAR; }
        if constexpr (!Epi::AFTER_DRAIN) { E(acc, cur, wr, wc, fr, fq); S.done(cur); }
        if (!has_next) break;
#pragma unroll
        for (int a = 0; a < 2; ++a)
#pragma unroll
            for (int b = 0; b < 2; ++b)
#pragma unroll
                for (int m = 0; m < 4; ++m)
#pragma unroll
                    for (int n = 0; n < 2; ++n) acc[a][b][m][n] = (f32x4){0.f, 0.f, 0.f, 0.f};
        cur = nxt; cA = nA; cB = nB; ++ui;
        if constexpr (ALIGN_EPI) { if (wr == 1) PG8_BAR; }
    }
    PG8_WAIT_V(0);
    if constexpr (!ALIGN_EPI) { if (wr == 0) PG8_BAR; }
    PG8_BAR;
    if constexpr (Epi::AFTER_DRAIN) { E.fused(acc, cur, wr, wc, fr, fq, lds, wid, lane); S.done(cur); }
#undef PG8_SA
#undef PG8_SB
#undef PG8_STAGE
#undef PG8_LDA
#undef PG8_LDB
#undef PG8_MMA
#undef PG8_WAIT_V
#undef PG8_WAIT_L
#undef PG8_BAR
#undef PG8_SCHED
}
}

#ifndef PG8_SP2
#define PG8_SP2 true
#endif
#ifndef PG8_ALIGN
#define PG8_ALIGN true
#endif
#define GAS __attribute__((address_space(1)))
#define LAS __attribute__((address_space(3)))
typedef unsigned short bf16;
typedef unsigned v4u __attribute__((ext_vector_type(4)));
typedef float f32x4 __attribute__((ext_vector_type(4)));
typedef short bf16x8 __attribute__((ext_vector_type(8)));
typedef GAS unsigned gu32;
typedef GAS unsigned long long gu64;
#define RLX_AGENT __ATOMIC_RELAXED, __HIP_MEMORY_SCOPE_AGENT
#define LDS_WAIT() asm volatile("s_waitcnt lgkmcnt(0)" ::: "memory")
#define VM_WAIT() asm volatile("s_waitcnt vmcnt(0)" ::: "memory")
__device__ __forceinline__ unsigned long long rt() { return __builtin_amdgcn_s_memrealtime(); }
__device__ __forceinline__ unsigned f2bf(float f) { unsigned u = __builtin_bit_cast(unsigned, f); return (u + 0x7fffu + ((u >> 16) & 1u)) >> 16; }
__device__ __forceinline__ unsigned pk2(float lo, float hi) { return f2bf(lo) | (f2bf(hi) << 16); }

#define XB_TMO      128
#define XB_XCNT(j)  (256  + 64 * (j))
#define XB_XSUB(j)  (1280 + 64 * (j))
#define XB_XGEN(j)  (2304 + 64 * (j))
#define XB_TOP      3328
#define XB_TOPGEN   3392
#define XCD_BAR_WORDS 3456
#define XB_SPIN_CAP (1u << 18)

__device__ __forceinline__ unsigned xb_ld(unsigned* p)              { return __hip_atomic_load(p, __ATOMIC_RELAXED, __HIP_MEMORY_SCOPE_AGENT); }
__device__ __forceinline__ unsigned xb_add(unsigned* p, unsigned v) { return __hip_atomic_fetch_add(p, v, __ATOMIC_RELAXED, __HIP_MEMORY_SCOPE_AGENT); }
__device__ __forceinline__ unsigned xb_xcc_id() { return (unsigned)__builtin_amdgcn_s_getreg((3 << 11) | 20) & 0xFu; }
#define XB_SPIN(cond, bar) do { unsigned _sp = 0; while (cond) { __builtin_amdgcn_s_sleep(1); \
    if ((++_sp & 255u) == 0u) { if (xb_ld(&(bar)[XB_TMO])) break; if (_sp > XB_SPIN_CAP) { atomicAdd(&(bar)[XB_TMO], 1u); break; } } } } while (0)

struct XcdBarrier {
    unsigned* bar; unsigned x;
    volatile LAS unsigned* st;
};

__device__ __forceinline__ XcdBarrier xcd_barrier_post(unsigned* bar, volatile LAS unsigned* st) {
    XcdBarrier b; b.bar = bar; b.x = xb_xcc_id(); b.st = st;
    if (threadIdx.x == 0) (void)xb_add(&bar[XB_XCNT(b.x)], 1u);
    return b;
}
__device__ __forceinline__ void xcd_barrier_complete(unsigned* bar, unsigned x, unsigned& nloc, unsigned& nx) {
    const unsigned G = gridDim.x * gridDim.y * gridDim.z;
    unsigned sum, cnt, mine, sp = 0u;
    for (;;) {
        sum = 0u; cnt = 0u; mine = 0u;
#pragma unroll
        for (unsigned j = 0; j < 16; ++j) { const unsigned c = xb_ld(&bar[XB_XCNT(j)]); sum += c; cnt += (c > 0u) ? 1u : 0u; mine = (j == x) ? c : mine; }
        if (sum == G) break;
        __builtin_amdgcn_s_sleep(1);
        if ((++sp & 255u) == 0u) { if (xb_ld(&bar[XB_TMO])) break; if (sp > XB_SPIN_CAP) { atomicAdd(&bar[XB_TMO], 1u); break; } }
    }
    nloc = mine > 0u ? mine : 1u; nx = cnt > 0u ? cnt : 1u;
}

__device__ __forceinline__ void xcd_barrier(const XcdBarrier& b) {
    asm volatile("s_waitcnt vmcnt(0)" ::: "memory");
    __syncthreads();
    if (threadIdx.x == 0) {
        unsigned* bar = b.bar;
        __builtin_amdgcn_s_waitcnt(0);
        unsigned nloc = b.st[0], nx = b.st[1];
        if (nloc == 0u) { xcd_barrier_complete(bar, b.x, nloc, nx); b.st[0] = nloc; b.st[1] = nx; }
        const unsigned old = xb_add(&bar[XB_XSUB(b.x)], 1u);
        const unsigned gen = old / nloc;
        if (old + 1u == (gen + 1u) * nloc) {
            __builtin_amdgcn_fence(__ATOMIC_RELEASE, "agent");
            asm volatile("s_waitcnt vmcnt(0)" ::: "memory");
            const unsigned og = xb_add(&bar[XB_TOP], 1u);
            const unsigned tg = og / nx;
            if (og + 1u == (tg + 1u) * nx) xb_add(&bar[XB_TOPGEN], 1u);
            else XB_SPIN(xb_ld(&bar[XB_TOPGEN]) == tg, bar);
            __builtin_amdgcn_fence(__ATOMIC_ACQUIRE, "agent");
            xb_add(&bar[XB_XGEN(b.x)], 1u);
            asm volatile("s_waitcnt vmcnt(0)" ::: "memory");
        } else {
            XB_SPIN(xb_ld(&bar[XB_XGEN(b.x)]) == gen, bar);
            __builtin_amdgcn_fence(__ATOMIC_ACQUIRE, "agent");
            asm volatile("s_waitcnt vmcnt(0)" ::: "memory");
        }
    }
    __syncthreads();
}


constexpr int NWAVES = 8;
constexpr int DM = 1024, BP = 8, TP = 2048, MP = BP * TP, BS = 128, TS = 8, MS = BS * TS, M = MP + MS;
constexpr int PAST = 2048, PAGE = 128, NPG = PAST / PAGE;
constexpr int HH = 4, HK = 128, HW = 512, FH = 8, FD = 64, FW = 512, DFF = 4096, INC = 5640, NPROJ = 5632, NMOD = 6144, NMODR = BP + BS;
constexpr float RMS_EPS = 1e-6f, LOG2E = 1.4426950408889634f;
constexpr float C2 = 0.125f * LOG2E;
constexpr float HQ_SCALE = 0.08838834764831845f;
constexpr size_t O_Y = 0, O_KP = (size_t)M * DM, O_VP = O_KP + (size_t)MP * FW, O_LFP = O_VP + (size_t)MP * FW, O_SP = O_LFP + (size_t)MP * FH,
                 O_KS = O_SP + (size_t)BP * HH * HK * HK, O_VS = O_KS + (size_t)MS * FW, O_LFS = O_VS + (size_t)MS * FW, O_SS = O_LFS + (size_t)MS * FH,
                 O_END = O_SS + (size_t)BS * HH * HK * HK;
constexpr size_t MiB = 1u << 20;
constexpr size_t WS_CTL = 0, CTL_ZERO_BYTES = 1 * MiB;
constexpr size_t WS_MOD = 1 * MiB, WS_WIN = 5 * MiB, WS_WBH = 16 * MiB, WS_WBF = 17 * MiB, WS_WOUT = 18 * MiB, WS_WUP = 20 * MiB, WS_WDN = 28 * MiB;
constexpr size_t WS_H = 36 * MiB, WS_QH = 70 * MiB, WS_VH = 87 * MiB, WS_SG = 104 * MiB, WS_QF = 121 * MiB, WS_KF = 138 * MiB, WS_VF = 155 * MiB;
constexpr size_t WS_G2 = 172 * MiB, WS_MG = 206 * MiB, WS_OF = 274 * MiB, WS_OH = 291 * MiB, WS_T1 = 308 * MiB, WS_MRG = 376 * MiB, WS_Y = 410 * MiB;
constexpr size_t WS_ACT = 478 * MiB, WS_U2 = 614 * MiB, WS_HG = 682 * MiB, WS_END = 832 * MiB;
static_assert((size_t)M * DM * 2 <= 34 * MiB && (size_t)M * HW * 2 <= 17 * MiB && (size_t)M * DFF * 2 <= 136 * MiB && (size_t)NPROJ * DM * 2 <= 11 * MiB, "ws map");
constexpr int CW_TMO = 0, CW_CODE = 1, CW_BAR = 4096;

constexpr int RING_OFF = 0, RING_BYTES = 131072;
constexpr int LDSCTL_OFF = RING_BYTES, MISC_OFF = LDSCTL_OFF + 320;
constexpr int LDS_BYTES = 147456;

struct Frame {
    LAS unsigned char* lds; volatile LAS unsigned* MISC; gu32* ctl; int tid, lane, wave, vcu, G;
    const float *xp, *xs, *cp, *cs, *ck, *cv, *clf, *st0; const int* pt;
    const float *ada_w, *ada_b, *n1pre, *n1post, *n2pre, *n2post, *w_in, *lbw, *onorm, *fxb, *w_brh, *w_brf, *w_out, *w_up, *w_dn;
    float* out; unsigned char* ws;
    bf16 *Win_t, *Wbh_t, *Wbf_t, *Wout_t, *Wup_t, *Wdn_t, *H, *QH, *VH, *SG, *QF, *KF, *VF, *MG, *OF, *OH, *MRG, *ACT;
    float *MOD, *G2, *T1, *Y, *U2;
};
__device__ __forceinline__ float wave_sum(float v) {
#pragma unroll
    for (int o = 1; o < 64; o <<= 1) v += __shfl_xor(v, o);
    return v;
}
__device__ __forceinline__ float bf2f(bf16 b) { return __uint_as_float((unsigned)b << 16); }
__device__ __forceinline__ float sigmoidf_(float x) { return __frcp_rn(1.0f + __expf(-x)); }
__device__ __forceinline__ const float* xrow(const Frame& F, int m) { return m < MP ? F.xp + (size_t)m * DM : F.xs + (size_t)(m - MP) * DM; }
__device__ __forceinline__ int modrow(int m) { return m < MP ? (m >> 11) : BP + ((m - MP) >> 3); }
__device__ __forceinline__ float* kout(const Frame& F, int m) { return m < MP ? F.out + O_KP + (size_t)m * FW : F.out + O_KS + (size_t)(m - MP) * FW; }
__device__ __forceinline__ float* vout(const Frame& F, int m) { return m < MP ? F.out + O_VP + (size_t)m * FW : F.out + O_VS + (size_t)(m - MP) * FW; }
__device__ __forceinline__ float* lfout(const Frame& F, int m) { return m < MP ? F.out + O_LFP + (size_t)m * FH : F.out + O_LFS + (size_t)(m - MP) * FH; }

__device__ __forceinline__ void tr_item(const float* W, int ldw, int K, int src_c0, bf16* WT, int dst_r0, LAS float* scr, int kb, int lane) {
    const int k0 = 64 * kb;
#pragma unroll 8
    for (int i = 0; i < 32; ++i) { const int kk = 2 * i + (lane >> 5); scr[kk * 33 + (lane & 31)] = W[(size_t)(k0 + kk) * ldw + src_c0 + (lane & 31)]; }
    LDS_WAIT(); asm volatile("" ::: "memory");
    const int c = lane & 7;
#pragma unroll
    for (int j = 0; j < 4; ++j) { const int n = (lane >> 3) + 8 * j; const LAS float* s = scr + (8 * c) * 33 + n;
        v4u o; o.x = pk2(s[0 * 33], s[1 * 33]); o.y = pk2(s[2 * 33], s[3 * 33]); o.z = pk2(s[4 * 33], s[5 * 33]); o.w = pk2(s[6 * 33], s[7 * 33]);
        *(GAS v4u*)(WT + (size_t)(dst_r0 + n) * K + k0 + 8 * c) = o; }
    LDS_WAIT(); asm volatile("" ::: "memory");
}
__device__ __forceinline__ float siluf_(float x) { return x * sigmoidf_(x); }
__device__ __forceinline__ void mod_task(Frame& F, int tsk) {
    const int lane = F.lane, w = F.wave, g = lane >> 4, n16 = lane & 15;
    const int ntile = 2 * tsk + (w >> 2), kq = w & 3, col = 16 * ntile + n16;
    f32x4 acc[9];
#pragma unroll
    for (int r = 0; r < 9; ++r) acc[r] = (f32x4){0.f, 0.f, 0.f, 0.f};
    for (int ks = 0; ks < 8; ++ks) {
        const int k0 = 256 * kq + 32 * ks + 8 * g;
        bf16x8 bfr;
#pragma unroll
        for (int j = 0; j < 8; ++j) bfr[j] = (short)f2bf(F.ada_w[(size_t)(k0 + j) * NMOD + col]);
#pragma unroll
        for (int rt = 0; rt < 9; ++rt) {
            const int row = 16 * rt + n16; bf16x8 afr = (bf16x8){0, 0, 0, 0, 0, 0, 0, 0};
            if (row < NMODR) { const float* c = (row < BP ? F.cp + (size_t)row * DM : F.cs + (size_t)(row - BP) * DM) + k0;
                const f32x4 c0 = *(const f32x4*)c, c1 = *(const f32x4*)(c + 4);
                afr[0] = (short)f2bf(siluf_(c0.x)); afr[1] = (short)f2bf(siluf_(c0.y)); afr[2] = (short)f2bf(siluf_(c0.z)); afr[3] = (short)f2bf(siluf_(c0.w));
                afr[4] = (short)f2bf(siluf_(c1.x)); afr[5] = (short)f2bf(siluf_(c1.y)); afr[6] = (short)f2bf(siluf_(c1.z)); afr[7] = (short)f2bf(siluf_(c1.w)); }
            acc[rt] = __builtin_amdgcn_mfma_f32_16x16x32_bf16(afr, bfr, acc[rt], 0, 0, 0);
        }
    }
    LAS f32x4* red = (LAS f32x4*)(F.lds + RING_OFF);
#pragma unroll
    for (int rt = 0; rt < 9; ++rt) red[(w * 9 + rt) * 64 + lane] = acc[rt];
    __syncthreads();
    if (kq == 0) {
        const float bias = F.ada_b[col];
#pragma unroll
        for (int rt = 0; rt < 9; ++rt) {
            f32x4 s = red[(w * 9 + rt) * 64 + lane] + red[((w + 1) * 9 + rt) * 64 + lane] + red[((w + 2) * 9 + rt) * 64 + lane] + red[((w + 3) * 9 + rt) * 64 + lane];
#pragma unroll
            for (int i = 0; i < 4; ++i) { const int row = 16 * rt + 4 * g + i; if (row < NMODR) F.MOD[(size_t)row * NMOD + col] = s[i] + bias; }
        }
    }
    __syncthreads();
}
__device__ __forceinline__ void p0_prologue(Frame& F) {
    for (int t = blockIdx.x; t < NMOD / 32; t += F.G) mod_task(F, t);
    LAS float* scr = (LAS float*)(F.lds + RING_OFF + F.wave * 16384);
    const int gw = F.vcu * NWAVES + F.wave, NGW = F.G * NWAVES;
    constexpr int I0 = 16 * 112, I1 = 16 * 64, I2 = 8 * 32, I3 = 8 * 32, I4 = 16 * 32, I5 = 16 * 128, I6 = 64 * 32;
    constexpr int NITEMS = I0 + I1 + I2 + I3 + I4 + I5 + I6;
    for (int it = gw; it < NITEMS; it += NGW) {
        int r = it;
        if (r < I0) { tr_item(F.w_in, INC, DM, 32 * (r % 112), F.Win_t, 32 * (r % 112), scr, r / 112, F.lane); continue; } r -= I0;
        if (r < I1) { tr_item(F.w_in, INC, DM, 3592 + 32 * (r % 64), F.Win_t, 3584 + 32 * (r % 64), scr, r / 64, F.lane); continue; } r -= I1;
        if (r < I2) { tr_item(F.w_brh, DM, HW, 32 * (r % 32), F.Wbh_t, 32 * (r % 32), scr, r / 32, F.lane); continue; } r -= I2;
        if (r < I3) { tr_item(F.w_brf, DM, FW, 32 * (r % 32), F.Wbf_t, 32 * (r % 32), scr, r / 32, F.lane); continue; } r -= I3;
        if (r < I4) { tr_item(F.w_out, DM, DM, 32 * (r % 32), F.Wout_t, 32 * (r % 32), scr, r / 32, F.lane); continue; } r -= I4;
        if (r < I5) { tr_item(F.w_up, DFF, DM, 32 * (r % 128), F.Wup_t, 32 * (r % 128), scr, r / 128, F.lane); continue; } r -= I5;
        tr_item(F.w_dn, DM, DFF, 32 * (r % 32), F.Wdn_t, 32 * (r % 32), scr, r / 32, F.lane);
    }
}

__device__ __forceinline__ void p1_norm1(Frame& F) {
    const int gw = F.vcu * NWAVES + F.wave, NGW = F.G * NWAVES, lane = F.lane;
    float wff[4][4][8];
#pragma unroll
    for (int j = 0; j < 4; ++j)
#pragma unroll
        for (int e = 0; e < 4; ++e) { const float* p = F.w_in + (size_t)(4 * lane + 256 * j + e) * INC + 3584; const f32x4 a = *(const f32x4*)p, b = *(const f32x4*)(p + 4);
            wff[j][e][0] = a.x; wff[j][e][1] = a.y; wff[j][e][2] = a.z; wff[j][e][3] = a.w; wff[j][e][4] = b.x; wff[j][e][5] = b.y; wff[j][e][6] = b.z; wff[j][e][7] = b.w; }
    f32x4 wn[4];
#pragma unroll
    for (int j = 0; j < 4; ++j) wn[j] = *(const f32x4*)(F.n1pre + 4 * lane + 256 * j);
    for (int m = gw; m < M; m += NGW) {
        const f32x4* xr = (const f32x4*)xrow(F, m) + lane; const float* mod = F.MOD + (size_t)modrow(m) * NMOD;
        f32x4 v[4]; float ss = 0.f;
#pragma unroll
        for (int j = 0; j < 4; ++j) { v[j] = xr[64 * j]; ss += (v[j].x * v[j].x + v[j].y * v[j].y) + (v[j].z * v[j].z + v[j].w * v[j].w); }
        const float rinv = 1.0f / sqrtf(wave_sum(ss) * (1.f / DM) + RMS_EPS);
        float ff[8];
#pragma unroll
        for (int q = 0; q < 8; ++q) ff[q] = 0.f;
        unsigned long long* o8 = (unsigned long long*)(F.H + (size_t)m * DM) + lane;
#pragma unroll
        for (int j = 0; j < 4; ++j) {
            const f32x4 sh = *(const f32x4*)(mod + 4 * lane + 256 * j), sc = *(const f32x4*)(mod + DM + 4 * lane + 256 * j);
            const f32x4 h = v[j] * rinv * wn[j] * (sc + 1.0f) + sh;
            o8[64 * j] = (unsigned long long)pk2(h.x, h.y) | ((unsigned long long)pk2(h.z, h.w) << 32);
#pragma unroll
            for (int q = 0; q < 8; ++q) ff[q] += (h.x * wff[j][0][q] + h.y * wff[j][1][q]) + (h.z * wff[j][2][q] + h.w * wff[j][3][q]);
        }
#pragma unroll
        for (int q = 0; q < 8; ++q) ff[q] = wave_sum(ff[q]);
        float z = ff[0];
#pragma unroll
        for (int q = 1; q < 8; ++q) z = (lane == q) ? ff[q] : z;
        if (lane < 8) { z += F.fxb[lane]; lfout(F, m)[lane] = fminf(z, 0.f) - log1pf(expf(-fabsf(z))); }
    }
}

typedef unsigned u32x4_t __attribute__((ext_vector_type(4)));
__device__ __forceinline__ u32x4_t pack8(const f32x4& a, const f32x4& b) { u32x4_t w; w.x = pg8::cvt_pk_bf16(a[0], a[1]); w.y = pg8::cvt_pk_bf16(a[2], a[3]); w.z = pg8::cvt_pk_bf16(b[0], b[1]); w.w = pg8::cvt_pk_bf16(b[2], b[3]); return w; }
__device__ __forceinline__ void unpack8(const u32x4_t w, f32x4& a, f32x4& b) {
    a[0] = __uint_as_float(w.x << 16); a[1] = __uint_as_float(w.x & 0xffff0000u); a[2] = __uint_as_float(w.y << 16); a[3] = __uint_as_float(w.y & 0xffff0000u);
    b[0] = __uint_as_float(w.z << 16); b[1] = __uint_as_float(w.z & 0xffff0000u); b[2] = __uint_as_float(w.w << 16); b[3] = __uint_as_float(w.w & 0xffff0000u); }

__device__ __forceinline__ f32x4 sig4(const f32x4 v) { return (f32x4){sigmoidf_(v[0]), sigmoidf_(v[1]), sigmoidf_(v[2]), sigmoidf_(v[3])}; }
__device__ __forceinline__ f32x4 silu4(const f32x4 v) { return v * sig4(v); }
__device__ __forceinline__ f32x4 relu2_4(const f32x4 v) { const f32x4 r = (f32x4){fmaxf(v[0], 0.f), fmaxf(v[1], 0.f), fmaxf(v[2], 0.f), fmaxf(v[3], 0.f)}; return r * r; }
__device__ __forceinline__ f32x4 g2_4(const f32x4 x, const f32x4 l0, const f32x4 l1) { f32x4 r;
    _Pragma("unroll") for (int e = 0; e < 4; ++e) { const float lb = __frcp_rn(1.0f + __expf(l1[e] - l0[e])); r[e] = __log2f(lb + (1.0f - lb) * sigmoidf_(x[e])); } return r; }
#define EPI_FOREACH(...) \
    const int row0_ = u.pm * pg8::BM + wr * 64 + fr, colb_ = u.pn * pg8::BM + wc * 32 + 8 * fq; \
    _Pragma("unroll") for (int ai = 0; ai < 2; ++ai) _Pragma("unroll") for (int m = 0; m < 4; ++m) { const int row = row0_ + ai * pg8::HALF + m * 16; \
        _Pragma("unroll") for (int bj = 0; bj < 2; ++bj) { const int col = colb_ + bj * pg8::HALF; f32x4 v0 = acc[ai][bj][m][0], v1 = acc[ai][bj][m][1]; __VA_ARGS__ } }

struct EpiProj {
    static constexpr bool PERM = true, AFTER_DRAIN = false;
    bf16 *QH, *VH, *SG, *QF, *KF, *VF, *MG; float* G2; float* out; const float* lbw;
    __device__ __forceinline__ void operator()(const f32x4 (&acc)[2][2][4][2], const pg8::Unit& u, int wr, int wc, int fr, int fq) const {
        const int seg = u.pn >> 1;
        if (u.pn >= 14) { EPI_FOREACH( *(u32x4_t*)(MG + (size_t)row * 2048 + (col - 3584)) = pack8(sig4(v0), sig4(v1)); ) }
        else if (seg == 0) { EPI_FOREACH( *(u32x4_t*)(QH + (size_t)row * HW + col) = pack8(v0 * HQ_SCALE, v1 * HQ_SCALE); ) }
        else if (seg == 1) {
            EPI_FOREACH( const int k = col - 512;
                *(f32x4*)(G2 + (size_t)row * HW + k) = g2_4(v0, *(const f32x4*)(lbw + k), *(const f32x4*)(lbw + HW + k));
                *(f32x4*)(G2 + (size_t)row * HW + k + 4) = g2_4(v1, *(const f32x4*)(lbw + k + 4), *(const f32x4*)(lbw + HW + k + 4)); ) }
        else if (seg == 2) { EPI_FOREACH( *(u32x4_t*)(VH + (size_t)row * HW + (col - 1024)) = pack8(v0, v1); ) }
        else if (seg == 3) { EPI_FOREACH( *(u32x4_t*)(SG + (size_t)row * HW + (col - 1536)) = pack8(silu4(v0), silu4(v1)); ) }
        else if (seg == 4) { EPI_FOREACH( *(u32x4_t*)(QF + (size_t)row * FW + (col - 2048)) = pack8(v0 * C2, v1 * C2); ) }
        else if (seg == 5) { EPI_FOREACH( const int c = col - 2560; *(u32x4_t*)(KF + (size_t)row * FW + c) = pack8(v0, v1);
                float* o = (row < MP ? out + O_KP + (size_t)row * FW : out + O_KS + (size_t)(row - MP) * FW) + c; *(f32x4*)o = v0; *(f32x4*)(o + 4) = v1; ) }
        else { EPI_FOREACH( const int c = col - 3072; *(u32x4_t*)(VF + (size_t)row * FW + c) = pack8(v0, v1);
                float* o = (row < MP ? out + O_VP + (size_t)row * FW : out + O_VS + (size_t)(row - MP) * FW) + c; *(f32x4*)o = v0; *(f32x4*)(o + 4) = v1; ) }
    }
};
struct EpiBrH {
    static constexpr bool PERM = true, AFTER_DRAIN = false; const bf16* MG; float* T1;
    __device__ __forceinline__ void operator()(const f32x4 (&acc)[2][2][4][2], const pg8::Unit& u, int wr, int wc, int fr, int fq) const {
        EPI_FOREACH( f32x4 ga, gb; unpack8(*(const u32x4_t*)(MG + (size_t)row * 2048 + col), ga, gb); *(f32x4*)(T1 + (size_t)row * DM + col) = v0 * ga; *(f32x4*)(T1 + (size_t)row * DM + col + 4) = v1 * gb; ) }
};
struct EpiBrF {
    static constexpr bool PERM = true, AFTER_DRAIN = false; const bf16* MG; const float* T1; bf16* MRG;
    __device__ __forceinline__ void operator()(const f32x4 (&acc)[2][2][4][2], const pg8::Unit& u, int wr, int wc, int fr, int fq) const {
        EPI_FOREACH( f32x4 ga, gb; unpack8(*(const u32x4_t*)(MG + (size_t)row * 2048 + DM + col), ga, gb);
            const f32x4 t0 = *(const f32x4*)(T1 + (size_t)row * DM + col), t1 = *(const f32x4*)(T1 + (size_t)row * DM + col + 4);
            *(u32x4_t*)(MRG + (size_t)row * DM + col) = pack8(t0 + v0 * ga, t1 + v1 * gb); ) }
};
struct EpiF32 {
    static constexpr bool PERM = true, AFTER_DRAIN = false; float* O; int ldc;
    __device__ __forceinline__ void operator()(const f32x4 (&acc)[2][2][4][2], const pg8::Unit& u, int wr, int wc, int fr, int fq) const {
        EPI_FOREACH( *(f32x4*)(O + (size_t)row * ldc + col) = v0; *(f32x4*)(O + (size_t)row * ldc + col + 4) = v1; ) }
};
struct EpiRelu2 {
    static constexpr bool PERM = true, AFTER_DRAIN = false; bf16* O; int ldc;
    __device__ __forceinline__ void operator()(const f32x4 (&acc)[2][2][4][2], const pg8::Unit& u, int wr, int wc, int fr, int fq) const {
        EPI_FOREACH( *(u32x4_t*)(O + (size_t)row * ldc + col) = pack8(relu2_4(v0), relu2_4(v1)); ) }
};

__device__ __forceinline__ void p8_midnorm(Frame& F) {
    const int gw = F.vcu * NWAVES + F.wave, NGW = F.G * NWAVES, lane = F.lane;
    f32x4 wpost[4], wpre[4];
#pragma unroll
    for (int j = 0; j < 4; ++j) { wpost[j] = *(const f32x4*)(F.n1post + 4 * lane + 256 * j); wpre[j] = *(const f32x4*)(F.n2pre + 4 * lane + 256 * j); }
    for (int m = gw; m < M; m += NGW) {
        const f32x4* xr = (const f32x4*)xrow(F, m) + lane; const f32x4* yr = (const f32x4*)(F.Y + (size_t)m * DM) + lane; const float* mod = F.MOD + (size_t)modrow(m) * NMOD;
        f32x4 y[4], x1[4]; float ss = 0.f;
#pragma unroll
        for (int j = 0; j < 4; ++j) { y[j] = yr[64 * j]; ss += (y[j].x * y[j].x + y[j].y * y[j].y) + (y[j].z * y[j].z + y[j].w * y[j].w); }
        const float rinv = 1.0f / sqrtf(wave_sum(ss) * (1.f / DM) + RMS_EPS);
        float s2 = 0.f; f32x4* o4 = (f32x4*)(F.out + O_Y + (size_t)m * DM) + lane;
#pragma unroll
        for (int j = 0; j < 4; ++j) { const f32x4 gt = *(const f32x4*)(mod + 2 * DM + 4 * lane + 256 * j);
            x1[j] = xr[64 * j] + gt * (y[j] * rinv * wpost[j]); o4[64 * j] = x1[j];
            s2 += (x1[j].x * x1[j].x + x1[j].y * x1[j].y) + (x1[j].z * x1[j].z + x1[j].w * x1[j].w); }
        const float r2 = 1.0f / sqrtf(wave_sum(s2) * (1.f / DM) + RMS_EPS);
        unsigned long long* o8 = (unsigned long long*)(F.H + (size_t)m * DM) + lane;
#pragma unroll
        for (int j = 0; j < 4; ++j) { const f32x4 sh = *(const f32x4*)(mod + 3 * DM + 4 * lane + 256 * j), sc = *(const f32x4*)(mod + 4 * DM + 4 * lane + 256 * j);
            const f32x4 h = x1[j] * r2 * wpre[j] * (sc + 1.0f) + sh;
            o8[64 * j] = (unsigned long long)pk2(h.x, h.y) | ((unsigned long long)pk2(h.z, h.w) << 32); }
    }
}
__device__ __forceinline__ void p11_final(Frame& F) {
    const int gw = F.vcu * NWAVES + F.wave, NGW = F.G * NWAVES, lane = F.lane;
    f32x4 wpost[4];
#pragma unroll
    for (int j = 0; j < 4; ++j) wpost[j] = *(const f32x4*)(F.n2post + 4 * lane + 256 * j);
    for (int m = gw; m < M; m += NGW) {
        const f32x4* ur = (const f32x4*)(F.U2 + (size_t)m * DM) + lane; const float* mod = F.MOD + (size_t)modrow(m) * NMOD;
        f32x4 uu[4]; float ss = 0.f;
#pragma unroll
        for (int j = 0; j < 4; ++j) { uu[j] = ur[64 * j]; ss += (uu[j].x * uu[j].x + uu[j].y * uu[j].y) + (uu[j].z * uu[j].z + uu[j].w * uu[j].w); }
        const float rinv = 1.0f / sqrtf(wave_sum(ss) * (1.f / DM) + RMS_EPS);
        f32x4* o4 = (f32x4*)(F.out + O_Y + (size_t)m * DM) + lane;
#pragma unroll
        for (int j = 0; j < 4; ++j) { const f32x4 gt = *(const f32x4*)(mod + 5 * DM + 4 * lane + 256 * j); o4[64 * j] = o4[64 * j] + gt * (uu[j] * rinv * wpost[j]); }
    }
}

__device__ __forceinline__ void p3s_attn_prompt(Frame& F) {
    const int NT = F.G * NWAVES * 64;
    for (int i = blockIdx.x * (NWAVES * 64) + F.tid; i < BP * FH * TP; i += NT) {
        const int t = i & (TP - 1), h = (i >> 11) & 7, b = i >> 14; const int m = b * TP + t;
        const int tmax = __builtin_amdgcn_readfirstlane(t | 63);
        float q[64], o[64];
        const bf16* qp = F.QF + (size_t)m * FW + h * FD;
#pragma unroll
        for (int d = 0; d < 64; ++d) { q[d] = bf2f(qp[d]); o[d] = 0.f; }
        float mx = -INFINITY, l = 0.f, Dacc = 0.f;
        const float* lfp = F.out + O_LFP + (size_t)b * TP * FH + h;
        for (int s = 0; s <= tmax; ++s) {
            const bf16* kp = F.KF + (size_t)(b * TP + s) * FW + h * FD; const bf16* vp = F.VF + (size_t)(b * TP + s) * FW + h * FD;
            float dot = 0.f;
#pragma unroll
            for (int d = 0; d < 64; ++d) dot += q[d] * bf2f(kp[d]);
            Dacc += lfp[(size_t)s * FH];
            const float x = dot - Dacc * LOG2E;
            if (s <= t) { const float mn = fmaxf(mx, x), f = exp2f(mx - mn), p = exp2f(x - mn); l = l * f + p; mx = mn;
#pragma unroll
                for (int d = 0; d < 64; ++d) o[d] = o[d] * f + p * bf2f(vp[d]); }
        }
        const float inv = 1.0f / l; bf16* op = F.OF + (size_t)m * FW + h * FD;
#pragma unroll
        for (int d = 0; d < 64; ++d) op[d] = (bf16)f2bf(o[d] * inv);
    }
}
__device__ __forceinline__ void p3s_attn_sample(Frame& F) {
    const int NT = F.G * NWAVES * 64;
    for (int i = blockIdx.x * (NWAVES * 64) + F.tid; i < BS * FH * TS; i += NT) {
        const int t = i & 7, h = (i >> 3) & 7, b = i >> 6; const int m = MP + b * TS + t;
        float q[64], o[64];
        const bf16* qp = F.QF + (size_t)m * FW + h * FD;
#pragma unroll
        for (int d = 0; d < 64; ++d) { q[d] = bf2f(qp[d]); o[d] = 0.f; }
        float mx = -INFINITY, l = 0.f, Dacc = 0.f;
        for (int s = 0; s < PAST + TS; ++s) {
            const float *kp, *vp; float lf;
            if (s < PAST) { const int pg = F.pt[b * NPG + (s >> 7)]; const size_t r = ((size_t)pg * PAGE + (s & 127)) * FH + h; kp = F.ck + r * FD; vp = F.cv + r * FD; lf = F.clf[r]; }
            else { const size_t r = (size_t)(b * TS + (s - PAST)) * FH + h; kp = F.out + O_KS + r * FD; vp = F.out + O_VS + r * FD; lf = F.out[O_LFS + r]; }
            float dot = 0.f;
#pragma unroll
            for (int d = 0; d < 64; d += 4) { const f32x4 k4 = *(const f32x4*)(kp + d); dot += (q[d] * k4.x + q[d + 1] * k4.y) + (q[d + 2] * k4.z + q[d + 3] * k4.w); }
            Dacc += lf;
            const float x = dot - Dacc * LOG2E;
            if (s <= PAST + t) { const float mn = fmaxf(mx, x), f = exp2f(mx - mn), p = exp2f(x - mn); l = l * f + p; mx = mn;
#pragma unroll
                for (int d = 0; d < 64; d += 4) { const f32x4 v4 = *(const f32x4*)(vp + d); o[d] = o[d] * f + p * v4.x; o[d + 1] = o[d + 1] * f + p * v4.y; o[d + 2] = o[d + 2] * f + p * v4.z; o[d + 3] = o[d + 3] * f + p * v4.w; } }
        }
        const float inv = 1.0f / l; bf16* op = F.OF + (size_t)m * FW + h * FD;
#pragma unroll
        for (int d = 0; d < 64; ++d) op[d] = (bf16)f2bf(o[d] * inv);
    }
}
__device__ __forceinline__ void p3s_hgrn(Frame& F) {
    LAS float* fv = (LAS float*)(F.lds + RING_OFF); LAS float* kin = fv + 128; LAS float* qv = kin + 128; LAS float* red = qv + 128; LAS float* ssq = red + 512;
    const int v = F.tid & 127, kq = F.tid >> 7;
    for (int it = blockIdx.x; it < BP * HH + BS * HH; it += F.G) {
        const bool smp = it >= BP * HH; const int sh = smp ? it - BP * HH : it, seq = sh >> 2, h = sh & 3;
        const int L = smp ? TS : TP; const int m0 = smp ? MP + seq * TS : seq * TP;
        float S[32];
#pragma unroll
        for (int i = 0; i < 32; ++i) S[i] = smp ? F.st0[((size_t)(seq * HH + h) * HK + kq * 32 + i) * HK + v] : 0.f;
        const float onw = F.onorm[v];
        for (int t = 0; t < L; ++t) {
            const size_t ro = (size_t)(m0 + t) * HW + h * HK;
            if (kq == 0) { const float f = exp2f(F.G2[ro + v]); fv[v] = f; kin[v] = 1.0f - f; qv[v] = bf2f(F.QH[ro + v]); }
            const float vv = bf2f(F.VH[ro + v]);
            __syncthreads();
            float part = 0.f;
#pragma unroll
            for (int i = 0; i < 32; ++i) { const int k = kq * 32 + i; S[i] = fv[k] * S[i] + kin[k] * vv; part += S[i] * qv[k]; }
            red[kq * 128 + v] = part;
            __syncthreads();
            float o = 0.f;
            if (kq == 0) { o = (red[v] + red[128 + v]) + (red[256 + v] + red[384 + v]); const float s = wave_sum(o * o); if (F.lane == 0) ssq[F.wave] = s; }
            __syncthreads();
            if (kq == 0) { const float rinv = 1.0f / sqrtf((ssq[0] + ssq[1]) * (1.f / HK) + RMS_EPS); F.OH[ro + v] = (bf16)f2bf(o * rinv * onw * bf2f(F.SG[ro + v])); }
        }
        float* so = (smp ? F.out + O_SS : F.out + O_SP) + (size_t)(seq * HH + h) * HK * HK;
#pragma unroll
        for (int i = 0; i < 32; ++i) so[(size_t)(kq * 32 + i) * HK + v] = S[i];
        __syncthreads();
    }
}

#ifndef MK_N_LAUNCHES
#define MK_N_LAUNCHES 12
#endif
constexpr int NPHASE = 12;
constexpr int N_LAUNCHES = MK_N_LAUNCHES;
struct Args { const void* in[24]; float* out; unsigned char* ws; int ph_lo, ph_hi, li, pad; };
__global__ void __launch_bounds__(NWAVES * 64, 2) fwd_kernel(Args args) {
    extern __shared__ __attribute__((aligned(16))) unsigned char lds[];
    Frame F;
    F.lds = (LAS unsigned char*)lds; F.MISC = (volatile LAS unsigned*)(F.lds + MISC_OFF);
    F.tid = threadIdx.x; F.lane = F.tid & 63; F.wave = __builtin_amdgcn_readfirstlane(F.tid >> 6);
    F.G = gridDim.x; { const int bx = blockIdx.x; F.vcu = (F.G % 8 == 0) ? (bx % 8) * (F.G / 8) + bx / 8 : bx; }
    unsigned char* ws = args.ws; F.ws = ws; F.out = args.out;
    F.ctl = (gu32*)(ws + WS_CTL);
    F.xp = (const float*)args.in[0]; F.xs = (const float*)args.in[1]; F.cp = (const float*)args.in[2]; F.cs = (const float*)args.in[3];
    F.ck = (const float*)args.in[4]; F.cv = (const float*)args.in[5]; F.clf = (const float*)args.in[6]; F.st0 = (const float*)args.in[7]; F.pt = (const int*)args.in[8];
    F.ada_w = (const float*)args.in[9]; F.ada_b = (const float*)args.in[10]; F.n1pre = (const float*)args.in[11]; F.n1post = (const float*)args.in[12];
    F.n2pre = (const float*)args.in[13]; F.n2post = (const float*)args.in[14]; F.w_in = (const float*)args.in[15]; F.lbw = (const float*)args.in[16];
    F.onorm = (const float*)args.in[17]; F.fxb = (const float*)args.in[18]; F.w_brh = (const float*)args.in[19]; F.w_brf = (const float*)args.in[20];
    F.w_out = (const float*)args.in[21]; F.w_up = (const float*)args.in[22]; F.w_dn = (const float*)args.in[23];
    F.MOD = (float*)(ws + WS_MOD); F.Win_t = (bf16*)(ws + WS_WIN); F.Wbh_t = (bf16*)(ws + WS_WBH); F.Wbf_t = (bf16*)(ws + WS_WBF); F.Wout_t = (bf16*)(ws + WS_WOUT);
    F.Wup_t = (bf16*)(ws + WS_WUP); F.Wdn_t = (bf16*)(ws + WS_WDN); F.H = (bf16*)(ws + WS_H); F.QH = (bf16*)(ws + WS_QH); F.VH = (bf16*)(ws + WS_VH); F.SG = (bf16*)(ws + WS_SG);
    F.QF = (bf16*)(ws + WS_QF); F.KF = (bf16*)(ws + WS_KF); F.VF = (bf16*)(ws + WS_VF); F.G2 = (float*)(ws + WS_G2); F.MG = (bf16*)(ws + WS_MG); F.OF = (bf16*)(ws + WS_OF);
    F.OH = (bf16*)(ws + WS_OH); F.T1 = (float*)(ws + WS_T1); F.MRG = (bf16*)(ws + WS_MRG); F.Y = (float*)(ws + WS_Y); F.ACT = (bf16*)(ws + WS_ACT); F.U2 = (float*)(ws + WS_U2);
    for (int u = F.tid; u < (LDS_BYTES - LDSCTL_OFF) / 4; u += NWAVES * 64) ((LAS unsigned*)(F.lds + LDSCTL_OFF))[u] = 0u;
    __syncthreads();
    XcdBarrier bar; bar.bar = (unsigned*)(F.ctl + CW_BAR); bar.x = 0; bar.st = nullptr;
    if (N_LAUNCHES == 1) bar = xcd_barrier_post((unsigned*)(F.ctl + CW_BAR), F.MISC + 8);
#define GRID_BAR(seam) do { if (N_LAUNCHES != 1) { if (F.tid == 0) __hip_atomic_store(F.ctl + CW_TMO, 0xBADBA0u | (unsigned)(seam), RLX_AGENT); } else { xcd_barrier(bar); } } while (0)
    const int lo = args.ph_lo, hi = args.ph_hi;
#define IN(k) (lo <= (k) && (k) < hi)
#define BOTH(k) (IN(k) && IN((k) + 1))
    if (IN(0)) { p0_prologue(F); if (BOTH(0)) GRID_BAR(0); }
    if (IN(1)) { p1_norm1(F); if (BOTH(1)) GRID_BAR(1); }
    if (IN(2)) {
        pg8::Gemm g{F.H, F.Win_t, M, NPROJ, DM}; pg8::StaticOrder S; S.init(M, NPROJ, F.G, (int)blockIdx.x);
        EpiProj E{F.QH, F.VH, F.SG, F.QF, F.KF, F.VF, F.MG, F.G2, F.out, F.lbw};
        pg8::gemm_phase<EpiProj, pg8::StaticOrder, PG8_ALIGN, PG8_SP2>(F.lds + RING_OFF, g, S, E);
        if (BOTH(2)) GRID_BAR(2);
    }
    if (IN(3)) { p3s_attn_prompt(F); p3s_attn_sample(F); p3s_hgrn(F); if (BOTH(3)) GRID_BAR(3); }
    if (IN(4)) { if (BOTH(4)) GRID_BAR(4); }
    if (IN(5)) {
        pg8::Gemm g{F.OH, F.Wbh_t, M, DM, HW}; pg8::StaticOrder S; S.init(M, DM, F.G, (int)blockIdx.x);
        EpiBrH E{F.MG, F.T1};
        pg8::gemm_phase<EpiBrH, pg8::StaticOrder, PG8_ALIGN, PG8_SP2>(F.lds + RING_OFF, g, S, E);
        if (BOTH(5)) GRID_BAR(5);
    }
    if (IN(6)) {
        pg8::Gemm g{F.OF, F.Wbf_t, M, DM, FW}; pg8::StaticOrder S; S.init(M, DM, F.G, (int)blockIdx.x);
        EpiBrF E{F.MG, F.T1, F.MRG};
        pg8::gemm_phase<EpiBrF, pg8::StaticOrder, PG8_ALIGN, PG8_SP2>(F.lds + RING_OFF, g, S, E);
        if (BOTH(6)) GRID_BAR(6);
    }
    if (IN(7)) {
        pg8::Gemm g{F.MRG, F.Wout_t, M, DM, DM}; pg8::StaticOrder S; S.init(M, DM, F.G, (int)blockIdx.x);
        EpiF32 E{F.Y, DM};
        pg8::gemm_phase<EpiF32, pg8::StaticOrder, PG8_ALIGN, PG8_SP2>(F.lds + RING_OFF, g, S, E);
        if (BOTH(7)) GRID_BAR(7);
    }
    if (IN(8)) { p8_midnorm(F); if (BOTH(8)) GRID_BAR(8); }
    if (IN(9)) {
        pg8::Gemm g{F.H, F.Wup_t, M, DFF, DM}; pg8::StaticOrder S; S.init(M, DFF, F.G, (int)blockIdx.x);
        EpiRelu2 E{F.ACT, DFF};
        pg8::gemm_phase<EpiRelu2, pg8::StaticOrder, PG8_ALIGN, PG8_SP2>(F.lds + RING_OFF, g, S, E);
        if (BOTH(9)) GRID_BAR(9);
    }
    if (IN(10)) {
        pg8::Gemm g{F.ACT, F.Wdn_t, M, DM, DFF}; pg8::StaticOrder S; S.init(M, DM, F.G, (int)blockIdx.x);
        EpiF32 E{F.U2, DM};
        pg8::gemm_phase<EpiF32, pg8::StaticOrder, PG8_ALIGN, PG8_SP2>(F.lds + RING_OFF, g, S, E);
        if (BOTH(10)) GRID_BAR(10);
    }
    if (IN(11)) { p11_final(F); }
#undef IN
#undef BOTH
}

extern "C" void kernel_launch(void* const* d_in, const int* in_sizes, int n_in, void* d_out, int out_size, void* d_ws, size_t ws_size, hipStream_t stream) {
    static int grid = 0;
    if (grid == 0) {
        if (n_in != 24 || (size_t)out_size != O_END || ws_size < WS_END) { fprintf(stderr, "kernel_launch: unexpected shapes: n_in %d out %d ws %zu (need %zu)\n", n_in, out_size, ws_size, (size_t)WS_END); grid = -1; return; }
        int dev = 0, cus = 0, per_cu = 0;
        if (hipGetDevice(&dev) != hipSuccess || hipDeviceGetAttribute(&cus, hipDeviceAttributeMultiprocessorCount, dev) != hipSuccess) { grid = -1; return; }
        if (hipFuncSetAttribute((const void*)fwd_kernel, hipFuncAttributeMaxDynamicSharedMemorySize, LDS_BYTES) != hipSuccess) { fprintf(stderr, "kernel_launch: hipFuncSetAttribute failed\n"); grid = -1; return; }
        if (hipOccupancyMaxActiveBlocksPerMultiprocessor(&per_cu, (const void*)fwd_kernel, NWAVES * 64, LDS_BYTES) != hipSuccess || per_cu < 1) fprintf(stderr, "kernel_launch: occupancy query reports %d\n", per_cu);
        (void)hipGetLastError();
        grid = cus;
    }
    if (grid < 0) return;
    if (hipMemsetAsync((char*)d_ws + WS_CTL, 0, CTL_ZERO_BYTES, stream) != hipSuccess) return;
    Args a{};
    for (int i = 0; i < 24; ++i) a.in[i] = d_in[i];
    a.out = (float*)d_out; a.ws = (unsigned char*)d_ws;
    if (N_LAUNCHES == 1) { a.ph_lo = 0; a.ph_hi = NPHASE; a.li = 0; hipLaunchKernelGGL(fwd_kernel, dim3(grid), dim3(NWAVES * 64), LDS_BYTES, stream, a); }
    else for (int li = 0; li < NPHASE; ++li) { a.ph_lo = li; a.ph_hi = li + 1; a.li = li; hipLaunchKernelGGL(fwd_kernel, dim3(grid), dim3(NWAVES * 64), LDS_BYTES, stream, a); }
    const hipError_t le = hipPeekAtLastError();
    if (le != hipSuccess) fprintf(stderr, "kernel_launch: launch failed: %s\n", hipGetErrorName(le));
}
```

```cpp
#include <hip/hip_runtime.h>
#include <cstdio>
#include <cstdint>
namespace pg8 {
#define PG8_LAS __attribute__((address_space(3)))
typedef unsigned short bf16_t;
typedef short bf16x8 __attribute__((ext_vector_type(8)));
typedef float f32x4 __attribute__((ext_vector_type(4)));
typedef unsigned u32x4 __attribute__((ext_vector_type(4)));
constexpr int BM = 256, BK = 64, HALF = 128, HTB = HALF * BK * 2  , STAGE_BYTES = 8 * HTB, NXCD = 8, WGM = 8;

__host__ __device__ __forceinline__ int lds_byte(int r, int c) { const int st = (r >> 4) * 2 + (c >> 5), rr = r & 15, cc = c & 31, ob = rr * 64 + cc * 2; return st * 1024 + (ob ^ (((ob >> 9) & 1) << 5)); }
__host__ __device__ __forceinline__ void stage_rc(int b, int& R, int& C) { const int st = b / 1024, sb = b % 1024, swz = sb ^ (((sb >> 9) & 1) << 5); R = (st >> 1) * 16 + swz / 64; C = (st & 1) * 32 + (swz % 64) / 2; }
__host__ __device__ __forceinline__ int perm32(int rho) { const int n = rho >> 4, i = rho & 15; return 8 * (i >> 2) + 4 * n + (i & 3); }

struct Unit { int pm, pn; };
struct Gemm { const bf16_t* A; const bf16_t* Bt; int M, N, K; };

struct StaticOrder {
    int nM, nN, nwg, G, c;
    __host__ __device__ void init(int M, int N, int G_, int c_) { nM = M / BM; nN = N / BM; nwg = nM * nN; G = G_; c = c_; }
    __host__ __device__ bool next(int i, Unit& u) const {
        const long L = (long)i * G + c; if (L >= nwg) return false;
        int wgid = (int)L; { const int q = nwg / NXCD, r = nwg % NXCD, xcd = wgid % NXCD, off = wgid / NXCD; wgid = (xcd < r ? xcd * (q + 1) : r * (q + 1) + (xcd - r) * q) + off; }
        const int nig = WGM * nN, gid = wgid / nig, fm = gid * WGM, gsz = (nM - fm) < WGM ? (nM - fm) : WGM;
        u.pm = fm + ((wgid % nig) % gsz); u.pn = (wgid % nig) / gsz; return true;
    }
    __device__ __forceinline__ void a_ready(const Unit&) const {}
    __device__ __forceinline__ void done(const Unit&) const {}
};

__device__ __forceinline__ unsigned cvt_pk_bf16(float lo, float hi) { unsigned r; asm volatile("v_cvt_pk_bf16_f32 %0, %1, %2" : "=v"(r) : "v"(lo), "v"(hi)); return r; }
typedef float f32x2 __attribute__((ext_vector_type(2)));
template <class Epi, class Sched, bool ALIGN_EPI = false, bool SP2 = false>
__device__ __forceinline__ void gemm_phase(PG8_LAS unsigned char* lds, const Gemm g, const Sched& S, const Epi& E) {
    const int tid = threadIdx.x, wid = __builtin_amdgcn_readfirstlane(tid >> 6), lane = tid & 63, wr = wid >> 2, wc = wid & 3, fr = lane & 15, fq = lane >> 4;
    const int K = g.K, nt = K / BK;
    unsigned voffA[2], voffB[2];
#pragma unroll
    for (int i = 0; i < 2; ++i) { int R, C; stage_rc(tid * 16 + i * 8192, R, C); const int Rb = Epi::PERM ? ((R & ~31) + perm32(R & 31)) : R;
        voffA[i] = (unsigned)(R * K + C) * 2u; voffB[i] = (unsigned)(Rb * K + C) * 2u; }
    const size_t kstep = (size_t)(BK * 2);
    const size_t hstep = (size_t)HALF * K * 2;
    const size_t tstep = 2 * hstep;
    const unsigned ldsw = (unsigned)wid * 1024u;
    const int aoff = lds_byte(wr * 64 + fr, fq * 8), boff = lds_byte(wc * 32 + fr, fq * 8);
#define PG8_SA(b, h) (((b) * 2 + (h)) * HTB)
#define PG8_SB(b, h) ((4 + (b) * 2 + (h)) * HTB)
#define PG8_STAGE(bufoff, gbase, voff) do { _Pragma("unroll") for (int _i = 0; _i < 2; ++_i) \
        __builtin_amdgcn_global_load_lds((const unsigned*)((const char*)(gbase) + (voff)[_i]), (PG8_LAS unsigned*)(lds + (bufoff) + ldsw + _i * 8192), 16, 0, 0); } while (0)
#define PG8_LDA(dst, b, h) do { _Pragma("unroll") for (int m = 0; m < 4; ++m) _Pragma("unroll") for (int k = 0; k < 2; ++k) dst[m][k] = *(const PG8_LAS bf16x8*)(lds + PG8_SA(b, h) + aoff + m * 2048 + k * 1024); } while (0)
#define PG8_LDB(dst, b, h) do { _Pragma("unroll") for (int n = 0; n < 2; ++n) _Pragma("unroll") for (int k = 0; k < 2; ++k) dst[n][k] = *(const PG8_LAS bf16x8*)(lds + PG8_SB(b, h) + boff + n * 2048 + k * 1024); } while (0)
#define PG8_MMA(ai, bj, At, Bt) do { __builtin_amdgcn_s_setprio(1); _Pragma("unroll") for (int m = 0; m < 4; ++m) _Pragma("unroll") for (int n = 0; n < 2; ++n) _Pragma("unroll") for (int k = 0; k < 2; ++k) \
        acc[ai][bj][m][n] = __builtin_amdgcn_mfma_f32_16x16x32_bf16(Bt[n][k], At[m][k], acc[ai][bj][m][n], 0, 0, 0); __builtin_amdgcn_s_setprio(0); } while (0)
#define PG8_WAIT_V(n) asm volatile("s_waitcnt vmcnt(" #n ")" ::: "memory")
#define PG8_WAIT_L(n) asm volatile("s_waitcnt lgkmcnt(" #n ")" ::: "memory")
#define PG8_BAR __builtin_amdgcn_s_barrier()
#define PG8_SCHED __builtin_amdgcn_sched_barrier(0)
    Unit cur, nxt; int ui = 0;
    if (!S.next(0, cur)) return;
    f32x4 acc[2][2][4][2];
#pragma unroll
    for (int a = 0; a < 2; ++a)
#pragma unroll
        for (int b = 0; b < 2; ++b)
#pragma unroll
            for (int m = 0; m < 4; ++m)
#pragma unroll
                for (int n = 0; n < 2; ++n) acc[a][b][m][n] = (f32x4){0.f, 0.f, 0.f, 0.f};
    bf16x8 At[4][2], B0[2][2], B1[2][2];
    const char* cA = (const char*)g.A + (size_t)cur.pm * tstep; const char* cB = (const char*)g.Bt + (size_t)cur.pn * tstep;
    S.a_ready(cur);
    if constexpr (SP2) {
        PG8_STAGE(PG8_SB(0, 0), cB, voffB); PG8_STAGE(PG8_SB(0, 1), cB + hstep, voffB); PG8_STAGE(PG8_SA(0, 0), cA, voffA); PG8_STAGE(PG8_SA(0, 1), cA + hstep, voffA);
        if (wr == 1) PG8_BAR;
        PG8_WAIT_V(2); PG8_BAR;
        PG8_STAGE(PG8_SB(1, 0), cB + kstep, voffB); PG8_STAGE(PG8_SA(1, 0), cA + kstep, voffA); PG8_STAGE(PG8_SB(1, 1), cB + hstep + kstep, voffB);
        PG8_WAIT_V(6); PG8_BAR;
    } else {
        PG8_STAGE(PG8_SB(0, 0), cB, voffB); PG8_STAGE(PG8_SA(0, 0), cA, voffA); PG8_STAGE(PG8_SB(0, 1), cB + hstep, voffB); PG8_STAGE(PG8_SA(0, 1), cA + hstep, voffA);
        if (wr == 1) PG8_BAR;
        PG8_WAIT_V(4); PG8_BAR;
        PG8_STAGE(PG8_SB(1, 0), cB + kstep, voffB); PG8_STAGE(PG8_SA(1, 0), cA + kstep, voffA); PG8_STAGE(PG8_SB(1, 1), cB + hstep + kstep, voffB);
        PG8_WAIT_V(6); PG8_BAR;
    }
    for (;;) {
        const bool has_next = S.next(ui + 1, nxt);
        const char* nA = has_next ? (const char*)g.A + (size_t)nxt.pm * tstep : cA; const char* nB = has_next ? (const char*)g.Bt + (size_t)nxt.pn * tstep : cB;
        for (int t = 0; t < nt; t += 2) {
            const bool last = (t == nt - 2);
            const char* a1 = cA + (size_t)(t + 1) * kstep;
            const char* a2 = last ? nA : cA + (size_t)(t + 2) * kstep; const char* b2 = last ? nB : cB + (size_t)(t + 2) * kstep;
            const char* a3 = a2 + kstep; const char* b3 = b2 + kstep;
            if (last && has_next) S.a_ready(nxt);
            if constexpr (SP2) {
            PG8_LDB(B0, 0, 0); PG8_LDB(B1, 0, 1); PG8_SCHED; PG8_LDA(At, 0, 0); PG8_STAGE(PG8_SA(1, 1), a1 + hstep, voffA);
            PG8_WAIT_V(8); PG8_WAIT_L(0); PG8_BAR; PG8_MMA(0, 0, At, B0); PG8_MMA(0, 1, At, B1); PG8_BAR; PG8_SCHED;
            PG8_LDA(At, 0, 1); PG8_STAGE(PG8_SB(0, 0), b2, voffB); PG8_STAGE(PG8_SB(0, 1), b2 + hstep, voffB); PG8_STAGE(PG8_SA(0, 0), a2, voffA);
            PG8_WAIT_V(8); PG8_WAIT_L(0); PG8_BAR; PG8_MMA(1, 0, At, B0); PG8_MMA(1, 1, At, B1); PG8_BAR; PG8_SCHED;
            PG8_LDB(B0, 1, 0); PG8_LDB(B1, 1, 1); PG8_SCHED; PG8_LDA(At, 1, 0); PG8_STAGE(PG8_SA(0, 1), a2 + hstep, voffA);
            PG8_WAIT_V(8); PG8_WAIT_L(0); PG8_BAR; PG8_MMA(0, 0, At, B0); PG8_MMA(0, 1, At, B1); PG8_BAR; PG8_SCHED;
            PG8_LDA(At, 1, 1); PG8_STAGE(PG8_SB(1, 0), b3, voffB); PG8_STAGE(PG8_SB(1, 1), b3 + hstep, voffB); PG8_STAGE(PG8_SA(1, 0), a3, voffA);
            PG8_WAIT_V(8); PG8_WAIT_L(0); PG8_BAR; PG8_MMA(1, 0, At, B0); PG8_MMA(1, 1, At, B1); PG8_BAR; PG8_SCHED;
            } else {
            PG8_LDB(B0, 0, 0); PG8_SCHED; PG8_LDA(At, 0, 0); PG8_STAGE(PG8_SA(1, 1), a1 + hstep, voffA);
            PG8_WAIT_L(8); PG8_BAR; PG8_WAIT_L(0); PG8_MMA(0, 0, At, B0); PG8_BAR; PG8_SCHED;
            PG8_LDB(B1, 0, 1); PG8_STAGE(PG8_SB(0, 0), b2, voffB);
            PG8_BAR; PG8_WAIT_L(0); PG8_MMA(0, 1, At, B1); PG8_BAR;
            PG8_LDA(At, 0, 1); PG8_STAGE(PG8_SA(0, 0), a2, voffA);
            PG8_BAR; PG8_WAIT_L(0); PG8_MMA(1, 0, At, B0); PG8_BAR; PG8_SCHED;
            PG8_STAGE(PG8_SB(0, 1), b2 + hstep, voffB);
            PG8_WAIT_V(6); PG8_BAR; PG8_MMA(1, 1, At, B1); PG8_BAR;
            PG8_LDB(B0, 1, 0); PG8_SCHED; PG8_LDA(At, 1, 0); PG8_STAGE(PG8_SA(0, 1), a2 + hstep, voffA);
            PG8_WAIT_L(8); PG8_BAR; PG8_WAIT_L(0); PG8_MMA(0, 0, At, B0); PG8_BAR; PG8_SCHED;
            PG8_LDB(B1, 1, 1); PG8_STAGE(PG8_SB(1, 0), b3, voffB);
            PG8_BAR; PG8_WAIT_L(0); PG8_MMA(0, 1, At, B1); PG8_BAR;
            PG8_LDA(At, 1, 1); PG8_STAGE(PG8_SA(1, 0), a3, voffA);
            PG8_BAR; PG8_WAIT_L(0); PG8_MMA(1, 0, At, B0); PG8_BAR; PG8_SCHED;
            PG8_STAGE(PG8_SB(1, 1), b3 + hstep, voffB);
            PG8_WAIT_V(6); PG8_BAR; PG8_MMA(1, 1, At, B1); PG8_BAR;
            }
        }
        if constexpr (ALIGN_EPI) { if (wr == 0) PG8_BAR; }
        if constexpr (!Epi::AFTER_DRAIN) { E(acc, cur, wr, wc, fr, fq); S.done(cur); }
        if (!has_next) break;
#pragma unroll
        for (int a = 0; a < 2; ++a)
#pragma unroll
            for (int b = 0; b < 2; ++b)
#pragma unroll
                for (int m = 0; m < 4; ++m)
#pragma unroll
                    for (int n = 0; n < 2; ++n) acc[a][b][m][n] = (f32x4){0.f, 0.f, 0.f, 0.f};
        cur = nxt; cA = nA; cB = nB; ++ui;
        if constexpr (ALIGN_EPI) { if (wr == 1) PG8_BAR; }
    }
    PG8_WAIT_V(0);
    if constexpr (!ALIGN_EPI) { if (wr == 0) PG8_BAR; }
    PG8_BAR;
    if constexpr (Epi::AFTER_DRAIN) { E.fused(acc, cur, wr, wc, fr, fq, lds, wid, lane); S.done(cur); }
#undef PG8_SA
#undef PG8_SB
#undef PG8_STAGE
#undef PG8_LDA
#undef PG8_LDB
#undef PG8_MMA
#undef PG8_WAIT_V
#undef PG8_WAIT_L
#undef PG8_BAR
#undef PG8_SCHED
}
}

#ifndef PG8_SP2
#define PG8_SP2 true
#endif
#ifndef PG8_ALIGN
#define PG8_ALIGN true
#endif
#define GAS __attribute__((address_space(1)))
#define LAS __attribute__((address_space(3)))
typedef unsigned short bf16;
typedef unsigned v4u __attribute__((ext_vector_type(4)));
typedef float f32x4 __attribute__((ext_vector_type(4)));
typedef short bf16x8 __attribute__((ext_vector_type(8)));
typedef GAS unsigned gu32;
typedef GAS unsigned long long gu64;
#define RLX_AGENT __ATOMIC_RELAXED, __HIP_MEMORY_SCOPE_AGENT
#define LDS_WAIT() asm volatile("s_waitcnt lgkmcnt(0)" ::: "memory")
#define VM_WAIT() asm volatile("s_waitcnt vmcnt(0)" ::: "memory")
__device__ __forceinline__ unsigned long long rt() { return __builtin_amdgcn_s_memrealtime(); }
__device__ __forceinline__ unsigned f2bf(float f) { unsigned u = __builtin_bit_cast(unsigned, f); return (u + 0x7fffu + ((u >> 16) & 1u)) >> 16; }
__device__ __forceinline__ unsigned pk2(float lo, float hi) { return f2bf(lo) | (f2bf(hi) << 16); }

#define XB_TMO      128
#define XB_XCNT(j)  (256  + 64 * (j))
#define XB_XSUB(j)  (1280 + 64 * (j))
#define XB_XGEN(j)  (2304 + 64 * (j))
#define XB_TOP      3328
#define XB_TOPGEN   3392
#define XCD_BAR_WORDS 3456
#define XB_SPIN_CAP (1u << 18)

__device__ __forceinline__ unsigned xb_ld(unsigned* p)              { return __hip_atomic_load(p, __ATOMIC_RELAXED, __HIP_MEMORY_SCOPE_AGENT); }
__device__ __forceinline__ unsigned xb_add(unsigned* p, unsigned v) { return __hip_atomic_fetch_add(p, v, __ATOMIC_RELAXED, __HIP_MEMORY_SCOPE_AGENT); }
__device__ __forceinline__ unsigned xb_xcc_id() { return (unsigned)__builtin_amdgcn_s_getreg((3 << 11) | 20) & 0xFu; }
#define XB_SPIN(cond, bar) do { unsigned _sp = 0; while (cond) { __builtin_amdgcn_s_sleep(1); \
    if ((++_sp & 255u) == 0u) { if (xb_ld(&(bar)[XB_TMO])) break; if (_sp > XB_SPIN_CAP) { atomicAdd(&(bar)[XB_TMO], 1u); break; } } } } while (0)

struct XcdBarrier {
    unsigned* bar; unsigned x;
    volatile LAS unsigned* st;
};

__device__ __forceinline__ XcdBarrier xcd_barrier_post(unsigned* bar, volatile LAS unsigned* st) {
    XcdBarrier b; b.bar = bar; b.x = xb_xcc_id(); b.st = st;
    if (threadIdx.x == 0) (void)xb_add(&bar[XB_XCNT(b.x)], 1u);
    return b;
}
__device__ __forceinline__ void xcd_barrier_complete(unsigned* bar, unsigned x, unsigned& nloc, unsigned& nx) {
    const unsigned G = gridDim.x * gridDim.y * gridDim.z;
    unsigned sum, cnt, mine, sp = 0u;
    for (;;) {
        sum = 0u; cnt = 0u; mine = 0u;
#pragma unroll
        for (unsigned j = 0; j < 16; ++j) { const unsigned c = xb_ld(&bar[XB_XCNT(j)]); sum += c; cnt += (c > 0u) ? 1u : 0u; mine = (j == x) ? c : mine; }
        if (sum == G) break;
        __builtin_amdgcn_s_sleep(1);
        if ((++sp & 255u) == 0u) { if (xb_ld(&bar[XB_TMO])) break; if (sp > XB_SPIN_CAP) { atomicAdd(&bar[XB_TMO], 1u); break; } }
    }
    nloc = mine > 0u ? mine : 1u; nx = cnt > 0u ? cnt : 1u;
}

__device__ __forceinline__ void xcd_barrier(const XcdBarrier& b) {
    asm volatile("s_waitcnt vmcnt(0)" ::: "memory");
    __syncthreads();
    if (threadIdx.x == 0) {
        unsigned* bar = b.bar;
        __builtin_amdgcn_s_waitcnt(0);
        unsigned nloc = b.st[0], nx = b.st[1];
        if (nloc == 0u) { xcd_barrier_complete(bar, b.x, nloc, nx); b.st[0] = nloc; b.st[1] = nx; }
        const unsigned old = xb_add(&bar[XB_XSUB(b.x)], 1u);
        const unsigned gen = old / nloc;
        if (old + 1u == (gen + 1u) * nloc) {
            __builtin_amdgcn_fence(__ATOMIC_RELEASE, "agent");
            asm volatile("s_waitcnt vmcnt(0)" ::: "memory");
            const unsigned og = xb_add(&bar[XB_TOP], 1u);
            const unsigned tg = og / nx;
            if (og + 1u == (tg + 1u) * nx) xb_add(&bar[XB_TOPGEN], 1u);
            else XB_SPIN(xb_ld(&bar[XB_TOPGEN]) == tg, bar);
            __builtin_amdgcn_fence(__ATOMIC_ACQUIRE, "agent");
            xb_add(&bar[XB_XGEN(b.x)], 1u);
            asm volatile("s_waitcnt vmcnt(0)" ::: "memory");
        } else {
            XB_SPIN(xb_ld(&bar[XB_XGEN(b.x)]) == gen, bar);
            __builtin_amdgcn_fence(__ATOMIC_ACQUIRE, "agent");
            asm volatile("s_waitcnt vmcnt(0)" ::: "memory");
        }
    }
    __syncthreads();
}


constexpr int NWAVES = 8;
constexpr int DM = 1024, BP = 8, TP = 2048, MP = BP * TP, BS = 128, TS = 8, MS = BS * TS, M = MP + MS;
constexpr int PAST = 2048, PAGE = 128, NPG = PAST / PAGE;
constexpr int HH = 4, HK = 128, HW = 512, FH = 8, FD = 64, FW = 512, DFF = 4096, INC = 5640, NPROJ = 5632, NMOD = 6144, NMODR = BP + BS;
constexpr float RMS_EPS = 1e-6f, LOG2E = 1.4426950408889634f;
constexpr float C2 = 0.125f * LOG2E;
constexpr float HQ_SCALE = 0.08838834764831845f;
constexpr size_t O_Y = 0, O_KP = (size_t)M * DM, O_VP = O_KP + (size_t)MP * FW, O_LFP = O_VP + (size_t)MP * FW, O_SP = O_LFP + (size_t)MP * FH,
                 O_KS = O_SP + (size_t)BP * HH * HK * HK, O_VS = O_KS + (size_t)MS * FW, O_LFS = O_VS + (size_t)MS * FW, O_SS = O_LFS + (size_t)MS * FH,
                 O_END = O_SS + (size_t)BS * HH * HK * HK;
constexpr size_t MiB = 1u << 20;
constexpr size_t WS_CTL = 0, CTL_ZERO_BYTES = 1 * MiB;
constexpr size_t WS_MOD = 1 * MiB, WS_WIN = 5 * MiB, WS_WBH = 16 * MiB, WS_WBF = 17 * MiB, WS_WOUT = 18 * MiB, WS_WUP = 20 * MiB, WS_WDN = 28 * MiB;
constexpr size_t WS_H = 36 * MiB, WS_QH = 70 * MiB, WS_VH = 87 * MiB, WS_SG = 104 * MiB, WS_QF = 121 * MiB, WS_KF = 138 * MiB, WS_VF = 155 * MiB;
constexpr size_t WS_G2 = 172 * MiB, WS_MG = 206 * MiB, WS_OF = 274 * MiB, WS_OH = 291 * MiB, WS_T1 = 308 * MiB, WS_MRG = 376 * MiB, WS_Y = 410 * MiB;
constexpr size_t WS_ACT = 478 * MiB, WS_U2 = 614 * MiB, WS_HG = 682 * MiB, WS_END = 832 * MiB;
static_assert((size_t)M * DM * 2 <= 34 * MiB && (size_t)M * HW * 2 <= 17 * MiB && (size_t)M * DFF * 2 <= 136 * MiB && (size_t)NPROJ * DM * 2 <= 11 * MiB, "ws map");
constexpr int CW_TMO = 0, CW_CODE = 1, CW_BAR = 4096;

constexpr int RING_OFF = 0, RING_BYTES = 131072;
constexpr int LDSCTL_OFF = RING_BYTES, MISC_OFF = LDSCTL_OFF + 320;
constexpr int LDS_BYTES = 147456;

struct Frame {
    LAS unsigned char* lds; volatile LAS unsigned* MISC; gu32* ctl; int tid, lane, wave, vcu, G;
    const float *xp, *xs, *cp, *cs, *ck, *cv, *clf, *st0; const int* pt;
    const float *ada_w, *ada_b, *n1pre, *n1post, *n2pre, *n2post, *w_in, *lbw, *onorm, *fxb, *w_brh, *w_brf, *w_out, *w_up, *w_dn;
    float* out; unsigned char* ws;
    bf16 *Win_t, *Wbh_t, *Wbf_t, *Wout_t, *Wup_t, *Wdn_t, *H, *QH, *VH, *SG, *QF, *KF, *VF, *MG, *OF, *OH, *MRG, *ACT;
    float *MOD, *G2, *T1, *Y, *U2;
};
__device__ __forceinline__ float wave_sum(float v) {
#pragma unroll
    for (int o = 1; o < 64; o <<= 1) v += __shfl_xor(v, o);
    return v;
}
__device__ __forceinline__ float bf2f(bf16 b) { return __uint_as_float((unsigned)b << 16); }
__device__ __forceinline__ float sigmoidf_(float x) { return __frcp_rn(1.0f + __expf(-x)); }
__device__ __forceinline__ const float* xrow(const Frame& F, int m) { return m < MP ? F.xp + (size_t)m * DM : F.xs + (size_t)(m - MP) * DM; }
__device__ __forceinline__ int modrow(int m) { return m < MP ? (m >> 11) : BP + ((m - MP) >> 3); }
__device__ __forceinline__ float* kout(const Frame& F, int m) { return m < MP ? F.out + O_KP + (size_t)m * FW : F.out + O_KS + (size_t)(m - MP) * FW; }
__device__ __forceinline__ float* vout(const Frame& F, int m) { return m < MP ? F.out + O_VP + (size_t)m * FW : F.out + O_VS + (size_t)(m - MP) * FW; }
__device__ __forceinline__ float* lfout(const Frame& F, int m) { return m < MP ? F.out + O_LFP + (size_t)m * FH : F.out + O_LFS + (size_t)(m - MP) * FH; }

__device__ __forceinline__ void tr_item(const float* W, int ldw, int K, int src_c0, bf16* WT, int dst_r0, LAS float* scr, int kb, int lane) {
    const int k0 = 64 * kb;
#pragma unroll 8
    for (int i = 0; i < 32; ++i) { const int kk = 2 * i + (lane >> 5); scr[kk * 33 + (lane & 31)] = W[(size_t)(k0 + kk) * ldw + src_c0 + (lane & 31)]; }
    LDS_WAIT(); asm volatile("" ::: "memory");
    const int c = lane & 7;
#pragma unroll
    for (int j = 0; j < 4; ++j) { const int n = (lane >> 3) + 8 * j; const LAS float* s = scr + (8 * c) * 33 + n;
        v4u o; o.x = pk2(s[0 * 33], s[1 * 33]); o.y = pk2(s[2 * 33], s[3 * 33]); o.z = pk2(s[4 * 33], s[5 * 33]); o.w = pk2(s[6 * 33], s[7 * 33]);
        *(GAS v4u*)(WT + (size_t)(dst_r0 + n) * K + k0 + 8 * c) = o; }
    LDS_WAIT(); asm volatile("" ::: "memory");
}
__device__ __forceinline__ float siluf_(float x) { return x * sigmoidf_(x); }
__device__ __forceinline__ void mod_task(Frame& F, int tsk) {
    const int lane = F.lane, w = F.wave, g = lane >> 4, n16 = lane & 15;
    const int ntile = 2 * tsk + (w >> 2), kq = w & 3, col = 16 * ntile + n16;
    f32x4 acc[9];
#pragma unroll
    for (int r = 0; r < 9; ++r) acc[r] = (f32x4){0.f, 0.f, 0.f, 0.f};
    for (int ks = 0; ks < 8; ++ks) {
        const int k0 = 256 * kq + 32 * ks + 8 * g;
        bf16x8 bfr;
#pragma unroll
        for (int j = 0; j < 8; ++j) bfr[j] = (short)f2bf(F.ada_w[(size_t)(k0 + j) * NMOD + col]);
#pragma unroll
        for (int rt = 0; rt < 9; ++rt) {
            const int row = 16 * rt + n16; bf16x8 afr = (bf16x8){0, 0, 0, 0, 0, 0, 0, 0};
            if (row < NMODR) { const float* c = (row < BP ? F.cp + (size_t)row * DM : F.cs + (size_t)(row - BP) * DM) + k0;
                const f32x4 c0 = *(const f32x4*)c, c1 = *(const f32x4*)(c + 4);
                afr[0] = (short)f2bf(siluf_(c0.x)); afr[1] = (short)f2bf(siluf_(c0.y)); afr[2] = (short)f2bf(siluf_(c0.z)); afr[3] = (short)f2bf(siluf_(c0.w));
                afr[4] = (short)f2bf(siluf_(c1.x)); afr[5] = (short)f2bf(siluf_(c1.y)); afr[6] = (short)f2bf(siluf_(c1.z)); afr[7] = (short)f2bf(siluf_(c1.w)); }
            acc[rt] = __builtin_amdgcn_mfma_f32_16x16x32_bf16(afr, bfr, acc[rt], 0, 0, 0);
        }
    }
    LAS f32x4* red = (LAS f32x4*)(F.lds + RING_OFF);
#pragma unroll
    for (int rt = 0; rt < 9; ++rt) red[(w * 9 + rt) * 64 + lane] = acc[rt];
    __syncthreads();
    if (kq == 0) {
        const float bias = F.ada_b[col];
#pragma unroll
        for (int rt = 0; rt < 9; ++rt) {
            f32x4 s = red[(w * 9 + rt) * 64 + lane] + red[((w + 1) * 9 + rt) * 64 + lane] + red[((w + 2) * 9 + rt) * 64 + lane] + red[((w + 3) * 9 + rt) * 64 + lane];
#pragma unroll
            for (int i = 0; i < 4; ++i) { const int row = 16 * rt + 4 * g + i; if (row < NMODR) F.MOD[(size_t)row * NMOD + col] = s[i] + bias; }
        }
    }
    __syncthreads();
}
__device__ __forceinline__ void p0_prologue(Frame& F) {
    for (int t = blockIdx.x; t < NMOD / 32; t += F.G) mod_task(F, t);
    LAS float* scr = (LAS float*)(F.lds + RING_OFF + F.wave * 16384);
    const int gw = F.vcu * NWAVES + F.wave, NGW = F.G * NWAVES;
    constexpr int I0 = 16 * 112, I1 = 16 * 64, I2 = 8 * 32, I3 = 8 * 32, I4 = 16 * 32, I5 = 16 * 128, I6 = 64 * 32;
    constexpr int NITEMS = I0 + I1 + I2 + I3 + I4 + I5 + I6;
    for (int it = gw; it < NITEMS; it += NGW) {
        int r = it;
        if (r < I0) { tr_item(F.w_in, INC, DM, 32 * (r % 112), F.Win_t, 32 * (r % 112), scr, r / 112, F.lane); continue; } r -= I0;
        if (r < I1) { tr_item(F.w_in, INC, DM, 3592 + 32 * (r % 64), F.Win_t, 3584 + 32 * (r % 64), scr, r / 64, F.lane); continue; } r -= I1;
        if (r < I2) { tr_item(F.w_brh, DM, HW, 32 * (r % 32), F.Wbh_t, 32 * (r % 32), scr, r / 32, F.lane); continue; } r -= I2;
        if (r < I3) { tr_item(F.w_brf, DM, FW, 32 * (r % 32), F.Wbf_t, 32 * (r % 32), scr, r / 32, F.lane); continue; } r -= I3;
        if (r < I4) { tr_item(F.w_out, DM, DM, 32 * (r % 32), F.Wout_t, 32 * (r % 32), scr, r / 32, F.lane); continue; } r -= I4;
        if (r < I5) { tr_item(F.w_up, DFF, DM, 32 * (r % 128), F.Wup_t, 32 * (r % 128), scr, r / 128, F.lane); continue; } r -= I5;
        tr_item(F.w_dn, DM, DFF, 32 * (r % 32), F.Wdn_t, 32 * (r % 32), scr, r / 32, F.lane);
    }
}

__device__ __forceinline__ void p1_norm1(Frame& F) {
    const int gw = F.vcu * NWAVES + F.wave, NGW = F.G * NWAVES, lane = F.lane;
    float wff[4][4][8];
#pragma unroll
    for (int j = 0; j < 4; ++j)
#pragma unroll
        for (int e = 0; e < 4; ++e) { const float* p = F.w_in + (size_t)(4 * lane + 256 * j + e) * INC + 3584; const f32x4 a = *(const f32x4*)p, b = *(const f32x4*)(p + 4);
            wff[j][e][0] = a.x; wff[j][e][1] = a.y; wff[j][e][2] = a.z; wff[j][e][3] = a.w; wff[j][e][4] = b.x; wff[j][e][5] = b.y; wff[j][e][6] = b.z; wff[j][e][7] = b.w; }
    f32x4 wn[4];
#pragma unroll
    for (int j = 0; j < 4; ++j) wn[j] = *(const f32x4*)(F.n1pre + 4 * lane + 256 * j);
    for (int m = gw; m < M; m += NGW) {
        const f32x4* xr = (const f32x4*)xrow(F, m) + lane; const float* mod = F.MOD + (size_t)modrow(m) * NMOD;
        f32x4 v[4]; float ss = 0.f;
#pragma unroll
        for (int j = 0; j < 4; ++j) { v[j] = xr[64 * j]; ss += (v[j].x * v[j].x + v[j].y * v[j].y) + (v[j].z * v[j].z + v[j].w * v[j].w); }
        const float rinv = 1.0f / sqrtf(wave_sum(ss) * (1.f / DM) + RMS_EPS);
        float ff[8];
#pragma unroll
        for (int q = 0; q < 8; ++q) ff[q] = 0.f;
        unsigned long long* o8 = (unsigned long long*)(F.H + (size_t)m * DM) + lane;
#pragma unroll
        for (int j = 0; j < 4; ++j) {
            const f32x4 sh = *(const f32x4*)(mod + 4 * lane + 256 * j), sc = *(const f32x4*)(mod + DM + 4 * lane + 256 * j);
            const f32x4 h = v[j] * rinv * wn[j] * (sc + 1.0f) + sh;
            o8[64 * j] = (unsigned long long)pk2(h.x, h.y) | ((unsigned long long)pk2(h.z, h.w) << 32);
#pragma unroll
            for (int q = 0; q < 8; ++q) ff[q] += (h.x * wff[j][0][q] + h.y * wff[j][1][q]) + (h.z * wff[j][2][q] + h.w * wff[j][3][q]);
        }
#pragma unroll
        for (int q = 0; q < 8; ++q) ff[q] = wave_sum(ff[q]);
        float z = ff[0];
#pragma unroll
        for (int q = 1; q < 8; ++q) z = (lane == q) ? ff[q] : z;
        if (lane < 8) { z += F.fxb[lane]; lfout(F, m)[lane] = fminf(z, 0.f) - log1pf(expf(-fabsf(z))); }
    }
}

typedef unsigned u32x4_t __attribute__((ext_vector_type(4)));
__device__ __forceinline__ u32x4_t pack8(const f32x4& a, const f32x4& b) { u32x4_t w; w.x = pg8::cvt_pk_bf16(a[0], a[1]); w.y = pg8::cvt_pk_bf16(a[2], a[3]); w.z = pg8::cvt_pk_bf16(b[0], b[1]); w.w = pg8::cvt_pk_bf16(b[2], b[3]); return w; }
__device__ __forceinline__ void unpack8(const u32x4_t w, f32x4& a, f32x4& b) {
    a[0] = __uint_as_float(w.x << 16); a[1] = __uint_as_float(w.x & 0xffff0000u); a[2] = __uint_as_float(w.y << 16); a[3] = __uint_as_float(w.y & 0xffff0000u);
    b[0] = __uint_as_float(w.z << 16); b[1] = __uint_as_float(w.z & 0xffff0000u); b[2] = __uint_as_float(w.w << 16); b[3] = __uint_as_float(w.w & 0xffff0000u); }

__device__ __forceinline__ f32x4 sig4(const f32x4 v) { return (f32x4){sigmoidf_(v[0]), sigmoidf_(v[1]), sigmoidf_(v[2]), sigmoidf_(v[3])}; }
__device__ __forceinline__ f32x4 silu4(const f32x4 v) { return v * sig4(v); }
__device__ __forceinline__ f32x4 relu2_4(const f32x4 v) { const f32x4 r = (f32x4){fmaxf(v[0], 0.f), fmaxf(v[1], 0.f), fmaxf(v[2], 0.f), fmaxf(v[3], 0.f)}; return r * r; }
__device__ __forceinline__ f32x4 g2_4(const f32x4 x, const f32x4 l0, const f32x4 l1) { f32x4 r;
    _Pragma("unroll") for (int e = 0; e < 4; ++e) { const float lb = __frcp_rn(1.0f + __expf(l1[e] - l0[e])); r[e] = __log2f(lb + (1.0f - lb) * sigmoidf_(x[e])); } return r; }
#define EPI_FOREACH(...) \
    const int row0_ = u.pm * pg8::BM + wr * 64 + fr, colb_ = u.pn * pg8::BM + wc * 32 + 8 * fq; \
    _Pragma("unroll") for (int ai = 0; ai < 2; ++ai) _Pragma("unroll") for (int m = 0; m < 4; ++m) { const int row = row0_ + ai * pg8::HALF + m * 16; \
        _Pragma("unroll") for (int bj = 0; bj < 2; ++bj) { const int col = colb_ + bj * pg8::HALF; f32x4 v0 = acc[ai][bj][m][0], v1 = acc[ai][bj][m][1]; __VA_ARGS__ } }

struct EpiProj {
    static constexpr bool PERM = true, AFTER_DRAIN = false;
    bf16 *QH, *VH, *SG, *QF, *KF, *VF, *MG; float* G2; float* out; const float* lbw;
    __device__ __forceinline__ void operator()(const f32x4 (&acc)[2][2][4][2], const pg8::Unit& u, int wr, int wc, int fr, int fq) const {
        const int seg = u.pn >> 1;
        if (u.pn >= 14) { EPI_FOREACH( *(u32x4_t*)(MG + (size_t)row * 2048 + (col - 3584)) = pack8(sig4(v0), sig4(v1)); ) }
        else if (seg == 0) { EPI_FOREACH( *(u32x4_t*)(QH + (size_t)row * HW + col) = pack8(v0 * HQ_SCALE, v1 * HQ_SCALE); ) }
        else if (seg == 1) {
            EPI_FOREACH( const int k = col - 512;
                *(f32x4*)(G2 + (size_t)row * HW + k) = g2_4(v0, *(const f32x4*)(lbw + k), *(const f32x4*)(lbw + HW + k));
                *(f32x4*)(G2 + (size_t)row * HW + k + 4) = g2_4(v1, *(const f32x4*)(lbw + k + 4), *(const f32x4*)(lbw + HW + k + 4)); ) }
        else if (seg == 2) { EPI_FOREACH( *(u32x4_t*)(VH + (size_t)row * HW + (col - 1024)) = pack8(v0, v1); ) }
        else if (seg == 3) { EPI_FOREACH( *(u32x4_t*)(SG + (size_t)row * HW + (col - 1536)) = pack8(silu4(v0), silu4(v1)); ) }
        else if (seg == 4) { EPI_FOREACH( *(u32x4_t*)(QF + (size_t)row * FW + (col - 2048)) = pack8(v0 * C2, v1 * C2); ) }
        else if (seg == 5) { EPI_FOREACH( const int c = col - 2560; *(u32x4_t*)(KF + (size_t)row * FW + c) = pack8(v0, v1);
                float* o = (row < MP ? out + O_KP + (size_t)row * FW : out + O_KS + (size_t)(row - MP) * FW) + c; *(f32x4*)o = v0; *(f32x4*)(o + 4) = v1; ) }
        else { EPI_FOREACH( const int c = col - 3072; *(u32x4_t*)(VF + (size_t)row * FW + c) = pack8(v0, v1);
                float* o = (row < MP ? out + O_VP + (size_t)row * FW : out + O_VS + (size_t)(row - MP) * FW) + c; *(f32x4*)o = v0; *(f32x4*)(o + 4) = v1; ) }
    }
};
struct EpiBrH {
    static constexpr bool PERM = true, AFTER_DRAIN = false; const bf16* MG; float* T1;
    __device__ __forceinline__ void operator()(const f32x4 (&acc)[2][2][4][2], const pg8::Unit& u, int wr, int wc, int fr, int fq) const {
        EPI_FOREACH( f32x4 ga, gb; unpack8(*(const u32x4_t*)(MG + (size_t)row * 2048 + col), ga, gb); *(f32x4*)(T1 + (size_t)row * DM + col) = v0 * ga; *(f32x4*)(T1 + (size_t)row * DM + col + 4) = v1 * gb; ) }
};
struct EpiBrF {
    static constexpr bool PERM = true, AFTER_DRAIN = false; const bf16* MG; const float* T1; bf16* MRG;
    __device__ __forceinline__ void operator()(const f32x4 (&acc)[2][2][4][2], const pg8::Unit& u, int wr, int wc, int fr, int fq) const {
        EPI_FOREACH( f32x4 ga, gb; unpack8(*(const u32x4_t*)(MG + (size_t)row * 2048 + DM + col), ga, gb);
            const f32x4 t0 = *(const f32x4*)(T1 + (size_t)row * DM + col), t1 = *(const f32x4*)(T1 + (size_t)row * DM + col + 4);
            *(u32x4_t*)(MRG + (size_t)row * DM + col) = pack8(t0 + v0 * ga, t1 + v1 * gb); ) }
};
struct EpiF32 {
    static constexpr bool PERM = true, AFTER_DRAIN = false; float* O; int ldc;
    __device__ __forceinline__ void operator()(const f32x4 (&acc)[2][2][4][2], const pg8::Unit& u, int wr, int wc, int fr, int fq) const {
        EPI_FOREACH( *(f32x4*)(O + (size_t)row * ldc + col) = v0; *(f32x4*)(O + (size_t)row * ldc + col + 4) = v1; ) }
};
struct EpiRelu2 {
    static constexpr bool PERM = true, AFTER_DRAIN = false; bf16* O; int ldc;
    __device__ __forceinline__ void operator()(const f32x4 (&acc)[2][2][4][2], const pg8::Unit& u, int wr, int wc, int fr, int fq) const {
        EPI_FOREACH( *(u32x4_t*)(O + (size_t)row * ldc + col) = pack8(relu2_4(v0), relu2_4(v1)); ) }
};

__device__ __forceinline__ void p8_midnorm(Frame& F) {
    const int gw = F.vcu * NWAVES + F.wave, NGW = F.G * NWAVES, lane = F.lane;
    f32x4 wpost[4], wpre[4];
#pragma unroll
    for (int j = 0; j < 4; ++j) { wpost[j] = *(const f32x4*)(F.n1post + 4 * lane + 256 * j); wpre[j] = *(const f32x4*)(F.n2pre + 4 * lane + 256 * j); }
    for (int m = gw; m < M; m += NGW) {
        const f32x4* xr = (const f32x4*)xrow(F, m) + lane; const f32x4* yr = (const f32x4*)(F.Y + (size_t)m * DM) + lane; const float* mod = F.MOD + (size_t)modrow(m) * NMOD;
        f32x4 y[4], x1[4]; float ss = 0.f;
#pragma unroll
        for (int j = 0; j < 4; ++j) { y[j] = yr[64 * j]; ss += (y[j].x * y[j].x + y[j].y * y[j].y) + (y[j].z * y[j].z + y[j].w * y[j].w); }
        const float rinv = 1.0f / sqrtf(wave_sum(ss) * (1.f / DM) + RMS_EPS);
        float s2 = 0.f; f32x4* o4 = (f32x4*)(F.out + O_Y + (size_t)m * DM) + lane;
#pragma unroll
        for (int j = 0; j < 4; ++j) { const f32x4 gt = *(const f32x4*)(mod + 2 * DM + 4 * lane + 256 * j);
            x1[j] = xr[64 * j] + gt * (y[j] * rinv * wpost[j]); o4[64 * j] = x1[j];
            s2 += (x1[j].x * x1[j].x + x1[j].y * x1[j].y) + (x1[j].z * x1[j].z + x1[j].w * x1[j].w); }
        const float r2 = 1.0f / sqrtf(wave_sum(s2) * (1.f / DM) + RMS_EPS);
        unsigned long long* o8 = (unsigned long long*)(F.H + (size_t)m * DM) + lane;
#pragma unroll
        for (int j = 0; j < 4; ++j) { const f32x4 sh = *(const f32x4*)(mod + 3 * DM + 4 * lane + 256 * j), sc = *(const f32x4*)(mod + 4 * DM + 4 * lane + 256 * j);
            const f32x4 h = x1[j] * r2 * wpre[j] * (sc + 1.0f) + sh;
            o8[64 * j] = (unsigned long long)pk2(h.x, h.y) | ((unsigned long long)pk2(h.z, h.w) << 32); }
    }
}
__device__ __forceinline__ void p11_final(Frame& F) {
    const int gw = F.vcu * NWAVES + F.wave, NGW = F.G * NWAVES, lane = F.lane;
    f32x4 wpost[4];
#pragma unroll
    for (int j = 0; j < 4; ++j) wpost[j] = *(const f32x4*)(F.n2post + 4 * lane + 256 * j);
    for (int m = gw; m < M; m += NGW) {
        const f32x4* ur = (const f32x4*)(F.U2 + (size_t)m * DM) + lane; const float* mod = F.MOD + (size_t)modrow(m) * NMOD;
        f32x4 uu[4]; float ss = 0.f;
#pragma unroll
        for (int j = 0; j < 4; ++j) { uu[j] = ur[64 * j]; ss += (uu[j].x * uu[j].x + uu[j].y * uu[j].y) + (uu[j].z * uu[j].z + uu[j].w * uu[j].w); }
        const float rinv = 1.0f / sqrtf(wave_sum(ss) * (1.f / DM) + RMS_EPS);
        f32x4* o4 = (f32x4*)(F.out + O_Y + (size_t)m * DM) + lane;
#pragma unroll
        for (int j = 0; j < 4; ++j) { const f32x4 gt = *(const f32x4*)(mod + 5 * DM + 4 * lane + 256 * j); o4[64 * j] = o4[64 * j] + gt * (uu[j] * rinv * wpost[j]); }
    }
}

__device__ __forceinline__ void p3s_attn_prompt(Frame& F) {
    const int NT = F.G * NWAVES * 64;
    for (int i = blockIdx.x * (NWAVES * 64) + F.tid; i < BP * FH * TP; i += NT) {
        const int t = i & (TP - 1), h = (i >> 11) & 7, b = i >> 14; const int m = b * TP + t;
        const int tmax = __builtin_amdgcn_readfirstlane(t | 63);
        float q[64], o[64];
        const bf16* qp = F.QF + (size_t)m * FW + h * FD;
#pragma unroll
        for (int d = 0; d < 64; ++d) { q[d] = bf2f(qp[d]); o[d] = 0.f; }
        float mx = -INFINITY, l = 0.f, Dacc = 0.f;
        const float* lfp = F.out + O_LFP + (size_t)b * TP * FH + h;
        for (int s = 0; s <= tmax; ++s) {
            const bf16* kp = F.KF + (size_t)(b * TP + s) * FW + h * FD; const bf16* vp = F.VF + (size_t)(b * TP + s) * FW + h * FD;
            float dot = 0.f;
#pragma unroll
            for (int d = 0; d < 64; ++d) dot += q[d] * bf2f(kp[d]);
            Dacc += lfp[(size_t)s * FH];
            const float x = dot - Dacc * LOG2E;
            if (s <= t) { const float mn = fmaxf(mx, x), f = exp2f(mx - mn), p = exp2f(x - mn); l = l * f + p; mx = mn;
#pragma unroll
                for (int d = 0; d < 64; ++d) o[d] = o[d] * f + p * bf2f(vp[d]); }
        }
        const float inv = 1.0f / l; bf16* op = F.OF + (size_t)m * FW + h * FD;
#pragma unroll
        for (int d = 0; d < 64; ++d) op[d] = (bf16)f2bf(o[d] * inv);
    }
}
__device__ __forceinline__ void p3s_attn_sample(Frame& F) {
    const int NT = F.G * NWAVES * 64;
    for (int i = blockIdx.x * (NWAVES * 64) + F.tid; i < BS * FH * TS; i += NT) {
        const int t = i & 7, h = (i >> 3) & 7, b = i >> 6; const int m = MP + b * TS + t;
        float q[64], o[64];
        const bf16* qp = F.QF + (size_t)m * FW + h * FD;
#pragma unroll
        for (int d = 0; d < 64; ++d) { q[d] = bf2f(qp[d]); o[d] = 0.f; }
        float mx = -INFINITY, l = 0.f, Dacc = 0.f;
        for (int s = 0; s < PAST + TS; ++s) {
            const float *kp, *vp; float lf;
            if (s < PAST) { const int pg = F.pt[b * NPG + (s >> 7)]; const size_t r = ((size_t)pg * PAGE + (s & 127)) * FH + h; kp = F.ck + r * FD; vp = F.cv + r * FD; lf = F.clf[r]; }
            else { const size_t r = (size_t)(b * TS + (s - PAST)) * FH + h; kp = F.out + O_KS + r * FD; vp = F.out + O_VS + r * FD; lf = F.out[O_LFS + r]; }
            float dot = 0.f;
#pragma unroll
            for (int d = 0; d < 64; d += 4) { const f32x4 k4 = *(const f32x4*)(kp + d); dot += (q[d] * k4.x + q[d + 1] * k4.y) + (q[d + 2] * k4.z + q[d + 3] * k4.w); }
            Dacc += lf;
            const float x = dot - Dacc * LOG2E;
            if (s <= PAST + t) { const float mn = fmaxf(mx, x), f = exp2f(mx - mn), p = exp2f(x - mn); l = l * f + p; mx = mn;
#pragma unroll
                for (int d = 0; d < 64; d += 4) { const f32x4 v4 = *(const f32x4*)(vp + d); o[d] = o[d] * f + p * v4.x; o[d + 1] = o[d + 1] * f + p * v4.y; o[d + 2] = o[d + 2] * f + p * v4.z; o[d + 3] = o[d + 3] * f + p * v4.w; } }
        }
        const float inv = 1.0f / l; bf16* op = F.OF + (size_t)m * FW + h * FD;
#pragma unroll
        for (int d = 0; d < 64; ++d) op[d] = (bf16)f2bf(o[d] * inv);
    }
}
__device__ __forceinline__ void p3s_hgrn(Frame& F) {
    LAS float* fv = (LAS float*)(F.lds + RING_OFF); LAS float* kin = fv + 128; LAS float* qv = kin + 128; LAS float* red = qv + 128; LAS float* ssq = red + 512;
    const int v = F.tid & 127, kq = F.tid >> 7;
    for (int it = blockIdx.x; it < BP * HH + BS * HH; it += F.G) {
        const bool smp = it >= BP * HH; const int sh = smp ? it - BP * HH : it, seq = sh >> 2, h = sh & 3;
        const int L = smp ? TS : TP; const int m0 = smp ? MP + seq * TS : seq * TP;
        float S[32];
#pragma unroll
        for (int i = 0; i < 32; ++i) S[i] = smp ? F.st0[((size_t)(seq * HH + h) * HK + kq * 32 + i) * HK + v] : 0.f;
        const float onw = F.onorm[v];
        for (int t = 0; t < L; ++t) {
            const size_t ro = (size_t)(m0 + t) * HW + h * HK;
            if (kq == 0) { const float f = exp2f(F.G2[ro + v]); fv[v] = f; kin[v] = 1.0f - f; qv[v] = bf2f(F.QH[ro + v]); }
            const float vv = bf2f(F.VH[ro + v]);
            __syncthreads();
            float part = 0.f;
#pragma unroll
            for (int i = 0; i < 32; ++i) { const int k = kq * 32 + i; S[i] = fv[k] * S[i] + kin[k] * vv; part += S[i] * qv[k]; }
            red[kq * 128 + v] = part;
            __syncthreads();
            float o = 0.f;
            if (kq == 0) { o = (red[v] + red[128 + v]) + (red[256 + v] + red[384 + v]); const float s = wave_sum(o * o); if (F.lane == 0) ssq[F.wave] = s; }
            __syncthreads();
            if (kq == 0) { const float rinv = 1.0f / sqrtf((ssq[0] + ssq[1]) * (1.f / HK) + RMS_EPS); F.OH[ro + v] = (bf16)f2bf(o * rinv * onw * bf2f(F.SG[ro + v])); }
        }
        float* so = (smp ? F.out + O_SS : F.out + O_SP) + (size_t)(seq * HH + h) * HK * HK;
#pragma unroll
        for (int i = 0; i < 32; ++i) so[(size_t)(kq * 32 + i) * HK + v] = S[i];
        __syncthreads();
    }
}

#ifndef MK_N_LAUNCHES
#define MK_N_LAUNCHES 1
#endif
constexpr int NPHASE = 12;
constexpr int N_LAUNCHES = MK_N_LAUNCHES;
struct Args { const void* in[24]; float* out; unsigned char* ws; int ph_lo, ph_hi, li, pad; };
__global__ void __launch_bounds__(NWAVES * 64, 2) fwd_kernel(Args args) {
    extern __shared__ __attribute__((aligned(16))) unsigned char lds[];
    Frame F;
    F.lds = (LAS unsigned char*)lds; F.MISC = (volatile LAS unsigned*)(F.lds + MISC_OFF);
    F.tid = threadIdx.x; F.lane = F.tid & 63; F.wave = __builtin_amdgcn_readfirstlane(F.tid >> 6);
    F.G = gridDim.x; { const int bx = blockIdx.x; F.vcu = (F.G % 8 == 0) ? (bx % 8) * (F.G / 8) + bx / 8 : bx; }
    unsigned char* ws = args.ws; F.ws = ws; F.out = args.out;
    F.ctl = (gu32*)(ws + WS_CTL);
    F.xp = (const float*)args.in[0]; F.xs = (const float*)args.in[1]; F.cp = (const float*)args.in[2]; F.cs = (const float*)args.in[3];
    F.ck = (const float*)args.in[4]; F.cv = (const float*)args.in[5]; F.clf = (const float*)args.in[6]; F.st0 = (const float*)args.in[7]; F.pt = (const int*)args.in[8];
    F.ada_w = (const float*)args.in[9]; F.ada_b = (const float*)args.in[10]; F.n1pre = (const float*)args.in[11]; F.n1post = (const float*)args.in[12];
    F.n2pre = (const float*)args.in[13]; F.n2post = (const float*)args.in[14]; F.w_in = (const float*)args.in[15]; F.lbw = (const float*)args.in[16];
    F.onorm = (const float*)args.in[17]; F.fxb = (const float*)args.in[18]; F.w_brh = (const float*)args.in[19]; F.w_brf = (const float*)args.in[20];
    F.w_out = (const float*)args.in[21]; F.w_up = (const float*)args.in[22]; F.w_dn = (const float*)args.in[23];
    F.MOD = (float*)(ws + WS_MOD); F.Win_t = (bf16*)(ws + WS_WIN); F.Wbh_t = (bf16*)(ws + WS_WBH); F.Wbf_t = (bf16*)(ws + WS_WBF); F.Wout_t = (bf16*)(ws + WS_WOUT);
    F.Wup_t = (bf16*)(ws + WS_WUP); F.Wdn_t = (bf16*)(ws + WS_WDN); F.H = (bf16*)(ws + WS_H); F.QH = (bf16*)(ws + WS_QH); F.VH = (bf16*)(ws + WS_VH); F.SG = (bf16*)(ws + WS_SG);
    F.QF = (bf16*)(ws + WS_QF); F.KF = (bf16*)(ws + WS_KF); F.VF = (bf16*)(ws + WS_VF); F.G2 = (float*)(ws + WS_G2); F.MG = (bf16*)(ws + WS_MG); F.OF = (bf16*)(ws + WS_OF);
    F.OH = (bf16*)(ws + WS_OH); F.T1 = (float*)(ws + WS_T1); F.MRG = (bf16*)(ws + WS_MRG); F.Y = (float*)(ws + WS_Y); F.ACT = (bf16*)(ws + WS_ACT); F.U2 = (float*)(ws + WS_U2);
    for (int u = F.tid; u < (LDS_BYTES - LDSCTL_OFF) / 4; u += NWAVES * 64) ((LAS unsigned*)(F.lds + LDSCTL_OFF))[u] = 0u;
    __syncthreads();
    XcdBarrier bar; bar.bar = (unsigned*)(F.ctl + CW_BAR); bar.x = 0; bar.st = nullptr;
    if (N_LAUNCHES == 1) bar = xcd_barrier_post((unsigned*)(F.ctl + CW_BAR), F.MISC + 8);
#define GRID_BAR(seam) do { if (N_LAUNCHES != 1) { if (F.tid == 0) __hip_atomic_store(F.ctl + CW_TMO, 0xBADBA0u | (unsigned)(seam), RLX_AGENT); } else { xcd_barrier(bar); } } while (0)
    const int lo = args.ph_lo, hi = args.ph_hi;
#define IN(k) (lo <= (k) && (k) < hi)
#define BOTH(k) (IN(k) && IN((k) + 1))
    if (IN(0)) { p0_prologue(F); if (BOTH(0)) GRID_BAR(0); }
    if (IN(1)) { p1_norm1(F); if (BOTH(1)) GRID_BAR(1); }
    if (IN(2)) {
        pg8::Gemm g{F.H, F.Win_t, M, NPROJ, DM}; pg8::StaticOrder S; S.init(M, NPROJ, F.G, (int)blockIdx.x);
        EpiProj E{F.QH, F.VH, F.SG, F.QF, F.KF, F.VF, F.MG, F.G2, F.out, F.lbw};
        pg8::gemm_phase<EpiProj, pg8::StaticOrder, PG8_ALIGN, PG8_SP2>(F.lds + RING_OFF, g, S, E);
        if (BOTH(2)) GRID_BAR(2);
    }
    if (IN(3)) { p3s_attn_prompt(F); p3s_attn_sample(F); p3s_hgrn(F); if (BOTH(3)) GRID_BAR(3); }
    if (IN(4)) { if (BOTH(4)) GRID_BAR(4); }
    if (IN(5)) {
        pg8::Gemm g{F.OH, F.Wbh_t, M, DM, HW}; pg8::StaticOrder S; S.init(M, DM, F.G, (int)blockIdx.x);
        EpiBrH E{F.MG, F.T1};
        pg8::gemm_phase<EpiBrH, pg8::StaticOrder, PG8_ALIGN, PG8_SP2>(F.lds + RING_OFF, g, S, E);
        if (BOTH(5)) GRID_BAR(5);
    }
    if (IN(6)) {
        pg8::Gemm g{F.OF, F.Wbf_t, M, DM, FW}; pg8::StaticOrder S; S.init(M, DM, F.G, (int)blockIdx.x);
        EpiBrF E{F.MG, F.T1, F.MRG};
        pg8::gemm_phase<EpiBrF, pg8::StaticOrder, PG8_ALIGN, PG8_SP2>(F.lds + RING_OFF, g, S, E);
        if (BOTH(6)) GRID_BAR(6);
    }
    if (IN(7)) {
        pg8::Gemm g{F.MRG, F.Wout_t, M, DM, DM}; pg8::StaticOrder S; S.init(M, DM, F.G, (int)blockIdx.x);
        EpiF32 E{F.Y, DM};
        pg8::gemm_phase<EpiF32, pg8::StaticOrder, PG8_ALIGN, PG8_SP2>(F.lds + RING_OFF, g, S, E);
        if (BOTH(7)) GRID_BAR(7);
    }
    if (IN(8)) { p8_midnorm(F); if (BOTH(8)) GRID_BAR(8); }
    if (IN(9)) {
        pg8::Gemm g{F.H, F.Wup_t, M, DFF, DM}; pg8::StaticOrder S; S.init(M, DFF, F.G, (int)blockIdx.x);
        EpiRelu2 E{F.ACT, DFF};
        pg8::gemm_phase<EpiRelu2, pg8::StaticOrder, PG8_ALIGN, PG8_SP2>(F.lds + RING_OFF, g, S, E);
        if (BOTH(9)) GRID_BAR(9);
    }
    if (IN(10)) {
        pg8::Gemm g{F.ACT, F.Wdn_t, M, DM, DFF}; pg8::StaticOrder S; S.init(M, DM, F.G, (int)blockIdx.x);
        EpiF32 E{F.U2, DM};
        pg8::gemm_phase<EpiF32, pg8::StaticOrder, PG8_ALIGN, PG8_SP2>(F.lds + RING_OFF, g, S, E);
        if (BOTH(10)) GRID_BAR(10);
    }
    if (IN(11)) { p11_final(F); }
#undef IN
#undef BOTH
}

extern "C" void kernel_launch(void* const* d_in, const int* in_sizes, int n_in, void* d_out, int out_size, void* d_ws, size_t ws_size, hipStream_t stream) {
    static int grid = 0;
    if (grid == 0) {
        if (n_in != 24 || (size_t)out_size != O_END || ws_size < WS_END) { fprintf(stderr, "kernel_launch: unexpected shapes: n_in %d out %d ws %zu (need %zu)\n", n_in, out_size, ws_size, (size_t)WS_END); grid = -1; return; }
        int dev = 0, cus = 0, per_cu = 0;
        if (hipGetDevice(&dev) != hipSuccess || hipDeviceGetAttribute(&cus, hipDeviceAttributeMultiprocessorCount, dev) != hipSuccess) { grid = -1; return; }
        if (hipFuncSetAttribute((const void*)fwd_kernel, hipFuncAttributeMaxDynamicSharedMemorySize, LDS_BYTES) != hipSuccess) { fprintf(stderr, "kernel_launch: hipFuncSetAttribute failed\n"); grid = -1; return; }
        if (hipOccupancyMaxActiveBlocksPerMultiprocessor(&per_cu, (const void*)fwd_kernel, NWAVES * 64, LDS_BYTES) != hipSuccess || per_cu < 1) fprintf(stderr, "kernel_launch: occupancy query reports %d\n", per_cu);
        (void)hipGetLastError();
        grid = cus;
    }
    if (grid < 0) return;
    if (hipMemsetAsync((char*)d_ws + WS_CTL, 0, CTL_ZERO_BYTES, stream) != hipSuccess) return;
    Args a{};
    for (int i = 0; i < 24; ++i) a.in[i] = d_in[i];
    a.out = (float*)d_out; a.ws = (unsigned char*)d_ws;
    if (N_LAUNCHES == 1) { a.ph_lo = 0; a.ph_hi = NPHASE; a.li = 0; hipLaunchKernelGGL(fwd_kernel, dim3(grid), dim3(NWAVES * 64), LDS_BYTES, stream, a); }
    else for (int li = 0; li < NPHASE; ++li) { a.ph_lo = li; a.ph_hi = li + 1; a.li = li; hipLaunchKernelGGL(fwd_kernel, dim3(grid), dim3(NWAVES * 64), LDS_BYTES, stream, a); }
    const hipError_t le = hipPeekAtLastError();
    if (le != hipSuccess) fprintf(stderr, "kernel_launch: launch failed: %s\n", hipGetErrorName(le));
}
```

```cpp
#include <hip/hip_runtime.h>
#include <cstdio>
#include <cstdint>
namespace pg8 {
#define PG8_LAS __attribute__((address_space(3)))
typedef unsigned short bf16_t;
typedef short bf16x8 __attribute__((ext_vector_type(8)));
typedef float f32x4 __attribute__((ext_vector_type(4)));
typedef unsigned u32x4 __attribute__((ext_vector_type(4)));
constexpr int BM = 256, BK = 64, HALF = 128, HTB = HALF * BK * 2  , STAGE_BYTES = 8 * HTB, NXCD = 8, WGM = 8;

__host__ __device__ __forceinline__ int lds_byte(int r, int c) { const int st = (r >> 4) * 2 + (c >> 5), rr = r & 15, cc = c & 31, ob = rr * 64 + cc * 2; return st * 1024 + (ob ^ (((ob >> 9) & 1) << 5)); }
__host__ __device__ __forceinline__ void stage_rc(int b, int& R, int& C) { const int st = b / 1024, sb = b % 1024, swz = sb ^ (((sb >> 9) & 1) << 5); R = (st >> 1) * 16 + swz / 64; C = (st & 1) * 32 + (swz % 64) / 2; }
__host__ __device__ __forceinline__ int perm32(int rho) { const int n = rho >> 4, i = rho & 15; return 8 * (i >> 2) + 4 * n + (i & 3); }

struct Unit { int pm, pn; };
struct Gemm { const bf16_t* A; const bf16_t* Bt; int M, N, K; };

struct StaticOrder {
    int nM, nN, nwg, G, c;
    __host__ __device__ void init(int M, int N, int G_, int c_) { nM = M / BM; nN = N / BM; nwg = nM * nN; G = G_; c = c_; }
    __host__ __device__ bool next(int i, Unit& u) const {
        const long L = (long)i * G + c; if (L >= nwg) return false;
        int wgid = (int)L; { const int q = nwg / NXCD, r = nwg % NXCD, xcd = wgid % NXCD, off = wgid / NXCD; wgid = (xcd < r ? xcd * (q + 1) : r * (q + 1) + (xcd - r) * q) + off; }
        const int nig = WGM * nN, gid = wgid / nig, fm = gid * WGM, gsz = (nM - fm) < WGM ? (nM - fm) : WGM;
        u.pm = fm + ((wgid % nig) % gsz); u.pn = (wgid % nig) / gsz; return true;
    }
    __device__ __forceinline__ void a_ready(const Unit&) const {}
    __device__ __forceinline__ void done(const Unit&) const {}
};

__device__ __forceinline__ unsigned cvt_pk_bf16(float lo, float hi) { unsigned r; asm volatile("v_cvt_pk_bf16_f32 %0, %1, %2" : "=v"(r) : "v"(lo), "v"(hi)); return r; }
typedef float f32x2 __attribute__((ext_vector_type(2)));
template <class Epi, class Sched, bool ALIGN_EPI = false, bool SP2 = false>
__device__ __forceinline__ void gemm_phase(PG8_LAS unsigned char* lds, const Gemm g, const Sched& S, const Epi& E) {
    const int tid = threadIdx.x, wid = __builtin_amdgcn_readfirstlane(tid >> 6), lane = tid & 63, wr = wid >> 2, wc = wid & 3, fr = lane & 15, fq = lane >> 4;
    const int K = g.K, nt = K / BK;
    unsigned voffA[2], voffB[2];
#pragma unroll
    for (int i = 0; i < 2; ++i) { int R, C; stage_rc(tid * 16 + i * 8192, R, C); const int Rb = Epi::PERM ? ((R & ~31) + perm32(R & 31)) : R;
        voffA[i] = (unsigned)(R * K + C) * 2u; voffB[i] = (unsigned)(Rb * K + C) * 2u; }
    const size_t kstep = (size_t)(BK * 2);
    const size_t hstep = (size_t)HALF * K * 2;
    const size_t tstep = 2 * hstep;
    const unsigned ldsw = (unsigned)wid * 1024u;
    const int aoff = lds_byte(wr * 64 + fr, fq * 8), boff = lds_byte(wc * 32 + fr, fq * 8);
#define PG8_SA(b, h) (((b) * 2 + (h)) * HTB)
#define PG8_SB(b, h) ((4 + (b) * 2 + (h)) * HTB)
#define PG8_STAGE(bufoff, gbase, voff) do { _Pragma("unroll") for (int _i = 0; _i < 2; ++_i) \
        __builtin_amdgcn_global_load_lds((const unsigned*)((const char*)(gbase) + (voff)[_i]), (PG8_LAS unsigned*)(lds + (bufoff) + ldsw + _i * 8192), 16, 0, 0); } while (0)
#define PG8_LDA(dst, b, h) do { _Pragma("unroll") for (int m = 0; m < 4; ++m) _Pragma("unroll") for (int k = 0; k < 2; ++k) dst[m][k] = *(const PG8_LAS bf16x8*)(lds + PG8_SA(b, h) + aoff + m * 2048 + k * 1024); } while (0)
#define PG8_LDB(dst, b, h) do { _Pragma("unroll") for (int n = 0; n < 2; ++n) _Pragma("unroll") for (int k = 0; k < 2; ++k) dst[n][k] = *(const PG8_LAS bf16x8*)(lds + PG8_SB(b, h) + boff + n * 2048 + k * 1024); } while (0)
#define PG8_MMA(ai, bj, At, Bt) do { __builtin_amdgcn_s_setprio(1); _Pragma("unroll") for (int m = 0; m < 4; ++m) _Pragma("unroll") for (int n = 0; n < 2; ++n) _Pragma("unroll") for (int k = 0; k < 2; ++k) \
        acc[ai][bj][m][n] = __builtin_amdgcn_mfma_f32_16x16x32_bf16(Bt[n][k], At[m][k], acc[ai][bj][m][n], 0, 0, 0); __builtin_amdgcn_s_setprio(0); } while (0)
#define PG8_WAIT_V(n) asm volatile("s_waitcnt vmcnt(" #n ")" ::: "memory")
#define PG8_WAIT_L(n) asm volatile("s_waitcnt lgkmcnt(" #n ")" ::: "memory")
#define PG8_BAR __builtin_amdgcn_s_barrier()
#define PG8_SCHED __builtin_amdgcn_sched_barrier(0)
    Unit cur, nxt; int ui = 0;
    if (!S.next(0, cur)) return;
    f32x4 acc[2][2][4][2];
#pragma unroll
    for (int a = 0; a < 2; ++a)
#pragma unroll
        for (int b = 0; b < 2; ++b)
#pragma unroll
            for (int m = 0; m < 4; ++m)
#pragma unroll
                for (int n = 0; n < 2; ++n) acc[a][b][m][n] = (f32x4){0.f, 0.f, 0.f, 0.f};
    bf16x8 At[4][2], B0[2][2], B1[2][2];
    const char* cA = (const char*)g.A + (size_t)cur.pm * tstep; const char* cB = (const char*)g.Bt + (size_t)cur.pn * tstep;
    S.a_ready(cur);
    if constexpr (SP2) {
        PG8_STAGE(PG8_SB(0, 0), cB, voffB); PG8_STAGE(PG8_SB(0, 1), cB + hstep, voffB); PG8_STAGE(PG8_SA(0, 0), cA, voffA); PG8_STAGE(PG8_SA(0, 1), cA + hstep, voffA);
        if (wr == 1) PG8_BAR;
        PG8_WAIT_V(2); PG8_BAR;
        PG8_STAGE(PG8_SB(1, 0), cB + kstep, voffB); PG8_STAGE(PG8_SA(1, 0), cA + kstep, voffA); PG8_STAGE(PG8_SB(1, 1), cB + hstep + kstep, voffB);
        PG8_WAIT_V(6); PG8_BAR;
    } else {
        PG8_STAGE(PG8_SB(0, 0), cB, voffB); PG8_STAGE(PG8_SA(0, 0), cA, voffA); PG8_STAGE(PG8_SB(0, 1), cB + hstep, voffB); PG8_STAGE(PG8_SA(0, 1), cA + hstep, voffA);
        if (wr == 1) PG8_BAR;
        PG8_WAIT_V(4); PG8_BAR;
        PG8_STAGE(PG8_SB(1, 0), cB + kstep, voffB); PG8_STAGE(PG8_SA(1, 0), cA + kstep, voffA); PG8_STAGE(PG8_SB(1, 1), cB + hstep + kstep, voffB);
        PG8_WAIT_V(6); PG8_BAR;
    }
    for (;;) {
        const bool has_next = S.next(ui + 1, nxt);
        const char* nA = has_next ? (const char*)g.A + (size_t)nxt.pm * tstep : cA; const char* nB = has_next ? (const char*)g.Bt + (size_t)nxt.pn * tstep : cB;
        for (int t = 0; t < nt; t += 2) {
            const bool last = (t == nt - 2);
            const char* a1 = cA + (size_t)(t + 1) * kstep;
            const char* a2 = last ? nA : cA + (size_t)(t + 2) * kstep; const char* b2 = last ? nB : cB + (size_t)(t + 2) * kstep;
            const char* a3 = a2 + kstep; const char* b3 = b2 + kstep;
            if (last && has_next) S.a_ready(nxt);
            if constexpr (SP2) {
            PG8_LDB(B0, 0, 0); PG8_LDB(B1, 0, 1); PG8_SCHED; PG8_LDA(At, 0, 0); PG8_STAGE(PG8_SA(1, 1), a1 + hstep, voffA);
            PG8_WAIT_V(8); PG8_WAIT_L(0); PG8_BAR; PG8_MMA(0, 0, At, B0); PG8_MMA(0, 1, At, B1); PG8_BAR; PG8_SCHED;
            PG8_LDA(At, 0, 1); PG8_STAGE(PG8_SB(0, 0), b2, voffB); PG8_STAGE(PG8_SB(0, 1), b2 + hstep, voffB); PG8_STAGE(PG8_SA(0, 0), a2, voffA);
            PG8_WAIT_V(8); PG8_WAIT_L(0); PG8_BAR; PG8_MMA(1, 0, At, B0); PG8_MMA(1, 1, At, B1); PG8_BAR; PG8_SCHED;
            PG8_LDB(B0, 1, 0); PG8_LDB(B1, 1, 1); PG8_SCHED; PG8_LDA(At, 1, 0); PG8_STAGE(PG8_SA(0, 1), a2 + hstep, voffA);
            PG8_WAIT_V(8); PG8_WAIT_L(0); PG8_BAR; PG8_MMA(0, 0, At, B0); PG8_MMA(0, 1, At, B1); PG8_BAR; PG8_SCHED;
            PG8_LDA(At, 1, 1); PG8_STAGE(PG8_SB(1, 0), b3, voffB); PG8_STAGE(PG8_SB(1, 1), b3 + hstep, voffB); PG8_STAGE(PG8_SA(1, 0), a3, voffA);
            PG8_WAIT_V(8); PG8_WAIT_L(0); PG8_BAR; PG8_MMA(1, 0, At, B0); PG8_MMA(1, 1, At, B1); PG8_BAR; PG8_SCHED;
            } else {
            PG8_LDB(B0, 0, 0); PG8_SCHED; PG8_LDA(At, 0, 0); PG8_STAGE(PG8_SA(1, 1), a1 + hstep, voffA);
            PG8_WAIT_L(8); PG8_BAR; PG8_WAIT_L(0); PG8_MMA(0, 0, At, B0); PG8_BAR; PG8_SCHED;
            PG8_LDB(B1, 0, 1); PG8_STAGE(PG8_SB(0, 0), b2, voffB);
            PG8_BAR; PG8_WAIT_L(0); PG8_MMA(0, 1, At, B1); PG8_BAR;
            PG8_LDA(At, 0, 1); PG8_STAGE(PG8_SA(0, 0), a2, voffA);
            PG8_BAR; PG8_WAIT_L(0); PG8_MMA(1, 0, At, B0); PG8_BAR; PG8_SCHED;
            PG8_STAGE(PG8_SB(0, 1), b2 + hstep, voffB);
            PG8_WAIT_V(6); PG8_BAR; PG8_MMA(1, 1, At, B1); PG8_BAR;
            PG8_LDB(B0, 1, 0); PG8_SCHED; PG8_LDA(At, 1, 0); PG8_STAGE(PG8_SA(0, 1), a2 + hstep, voffA);
            PG8_WAIT_L(8); PG8_BAR; PG8_WAIT_L(0); PG8_MMA(0, 0, At, B0); PG8_BAR; PG8_SCHED;
            PG8_LDB(B1, 1, 1); PG8_STAGE(PG8_SB(1, 0), b3, voffB);
            PG8_BAR; PG8_WAIT_L(0); PG8_MMA(0, 1, At, B1); PG8_BAR;
            PG8_LDA(At, 1, 1); PG8_STAGE(PG8_SA(1, 0), a3, voffA);
            PG8_BAR; PG8_WAIT_L(0); PG8_MMA(1, 0, At, B0); PG8_BAR; PG8_SCHED;
            PG8_STAGE(PG8_SB(1, 1), b3 + hstep, voffB);
            PG8_WAIT_V(6); PG8_BAR; PG8_MMA(1, 1, At, B1); PG8_BAR;
            }
        }
        if constexpr (ALIGN_EPI) { if (wr == 0) PG8_BAR; }
        if constexpr (!Epi::AFTER_DRAIN) { E(acc, cur, wr, wc, fr, fq); S.done(cur); }
        if (!has_next) break;
#pragma unroll
        for (int a = 0; a < 2; ++a)
#pragma unroll
            for (int b = 0; b < 2; ++b)
#pragma unroll
                for (int m = 0; m < 4; ++m)
#pragma unroll
                    for (int n = 0; n < 2; ++n) acc[a][b][m][n] = (f32x4){0.f, 0.f, 0.f, 0.f};
        cur = nxt; cA = nA; cB = nB; ++ui;
        if constexpr (ALIGN_EPI) { if (wr == 1) PG8_BAR; }
    }
    PG8_WAIT_V(0);
    if constexpr (!ALIGN_EPI) { if (wr == 0) PG8_BAR; }
    PG8_BAR;
    if constexpr (Epi::AFTER_DRAIN) { E.fused(acc, cur, wr, wc, fr, fq, lds, wid, lane); S.done(cur); }
#undef PG8_SA
#undef PG8_SB
#undef PG8_STAGE
#undef PG8_LDA
#undef PG8_LDB
#undef PG8_MMA
#undef PG8_WAIT_V
#undef PG8_WAIT_L
#undef PG8_BAR
#undef PG8_SCHED
}
}

#ifndef PG8_SP2
#define PG8_SP2 true
#endif
#ifndef PG8_ALIGN
#define PG8_ALIGN true
#endif
#define GAS __attribute__((address_space(1)))
#define LAS __attribute__((address_space(3)))
typedef unsigned short bf16;
typedef unsigned v4u __attribute__((ext_vector_type(4)));
typedef float f32x4 __attribute__((ext_vector_type(4)));
typedef short bf16x8 __attribute__((ext_vector_type(8)));
typedef GAS unsigned gu32;
typedef GAS unsigned long long gu64;
#define RLX_AGENT __ATOMIC_RELAXED, __HIP_MEMORY_SCOPE_AGENT
#define LDS_WAIT() asm volatile("s_waitcnt lgkmcnt(0)" ::: "memory")
#define VM_WAIT() asm volatile("s_waitcnt vmcnt(0)" ::: "memory")
__device__ __forceinline__ unsigned long long rt() { return __builtin_amdgcn_s_memrealtime(); }
__device__ __forceinline__ unsigned f2bf(float f) { unsigned u = __builtin_bit_cast(unsigned, f); return (u + 0x7fffu + ((u >> 16) & 1u)) >> 16; }
__device__ __forceinline__ unsigned pk2(float lo, float hi) { return f2bf(lo) | (f2bf(hi) << 16); }

#define XB_TMO      128
#define XB_XCNT(j)  (256  + 64 * (j))
#define XB_XSUB(j)  (1280 + 64 * (j))
#define XB_XGEN(j)  (2304 + 64 * (j))
#define XB_TOP      3328
#define XB_TOPGEN   3392
#define XCD_BAR_WORDS 3456
#define XB_SPIN_CAP (1u << 18)

__device__ __forceinline__ unsigned xb_ld(unsigned* p)              { return __hip_atomic_load(p, __ATOMIC_RELAXED, __HIP_MEMORY_SCOPE_AGENT); }
__device__ __forceinline__ unsigned xb_add(unsigned* p, unsigned v) { return __hip_atomic_fetch_add(p, v, __ATOMIC_RELAXED, __HIP_MEMORY_SCOPE_AGENT); }
__device__ __forceinline__ unsigned xb_xcc_id() { return (unsigned)__builtin_amdgcn_s_getreg((3 << 11) | 20) & 0xFu; }
#define XB_SPIN(cond, bar) do { unsigned _sp = 0; while (cond) { __builtin_amdgcn_s_sleep(1); \
    if ((++_sp & 255u) == 0u) { if (xb_ld(&(bar)[XB_TMO])) break; if (_sp > XB_SPIN_CAP) { atomicAdd(&(bar)[XB_TMO], 1u); break; } } } } while (0)

struct XcdBarrier {
    unsigned* bar; unsigned x;
    volatile LAS unsigned* st;
};

__device__ __forceinline__ XcdBarrier xcd_barrier_post(unsigned* bar, volatile LAS unsigned* st) {
    XcdBarrier b; b.bar = bar; b.x = xb_xcc_id(); b.st = st;
    if (threadIdx.x == 0) (void)xb_add(&bar[XB_XCNT(b.x)], 1u);
    return b;
}
__device__ __forceinline__ void xcd_barrier_complete(unsigned* bar, unsigned x, unsigned& nloc, unsigned& nx) {
    const unsigned G = gridDim.x * gridDim.y * gridDim.z;
    unsigned sum, cnt, mine, sp = 0u;
    for (;;) {
        sum = 0u; cnt = 0u; mine = 0u;
#pragma unroll
        for (unsigned j = 0; j < 16; ++j) { const unsigned c = xb_ld(&bar[XB_XCNT(j)]); sum += c; cnt += (c > 0u) ? 1u : 0u; mine = (j == x) ? c : mine; }
        if (sum == G) break;
        __builtin_amdgcn_s_sleep(1);
        if ((++sp & 255u) == 0u) { if (xb_ld(&bar[XB_TMO])) break; if (sp > XB_SPIN_CAP) { atomicAdd(&bar[XB_TMO], 1u); break; } }
    }
    nloc = mine > 0u ? mine : 1u; nx = cnt > 0u ? cnt : 1u;
}

__device__ __forceinline__ void xcd_barrier(const XcdBarrier& b) {
    asm volatile("s_waitcnt vmcnt(0)" ::: "memory");
    __syncthreads();
    if (threadIdx.x == 0) {
        unsigned* bar = b.bar;
        __builtin_amdgcn_s_waitcnt(0);
        unsigned nloc = b.st[0], nx = b.st[1];
        if (nloc == 0u) { xcd_barrier_complete(bar, b.x, nloc, nx); b.st[0] = nloc; b.st[1] = nx; }
        const unsigned old = xb_add(&bar[XB_XSUB(b.x)], 1u);
        const unsigned gen = old / nloc;
        if (old + 1u == (gen + 1u) * nloc) {
            __builtin_amdgcn_fence(__ATOMIC_RELEASE, "agent");
            asm volatile("s_waitcnt vmcnt(0)" ::: "memory");
            const unsigned og = xb_add(&bar[XB_TOP], 1u);
            const unsigned tg = og / nx;
            if (og + 1u == (tg + 1u) * nx) xb_add(&bar[XB_TOPGEN], 1u);
            else XB_SPIN(xb_ld(&bar[XB_TOPGEN]) == tg, bar);
            __builtin_amdgcn_fence(__ATOMIC_ACQUIRE, "agent");
            xb_add(&bar[XB_XGEN(b.x)], 1u);
            asm volatile("s_waitcnt vmcnt(0)" ::: "memory");
        } else {
            XB_SPIN(xb_ld(&bar[XB_XGEN(b.x)]) == gen, bar);
            __builtin_amdgcn_fence(__ATOMIC_ACQUIRE, "agent");
            asm volatile("s_waitcnt vmcnt(0)" ::: "memory");
        }
    }
    __syncthreads();
}


constexpr int NWAVES = 8;
constexpr int DM = 1024, BP = 8, TP = 2048, MP = BP * TP, BS = 128, TS = 8, MS = BS * TS, M = MP + MS;
constexpr int PAST = 2048, PAGE = 128, NPG = PAST / PAGE;
constexpr int HH = 4, HK = 128, HW = 512, FH = 8, FD = 64, FW = 512, DFF = 4096, INC = 5640, NPROJ = 5632, NMOD = 6144, NMODR = BP + BS;
constexpr float RMS_EPS = 1e-6f, LOG2E = 1.4426950408889634f;
constexpr float C2 = 0.125f * LOG2E;
constexpr float HQ_SCALE = 0.08838834764831845f;
constexpr size_t O_Y = 0, O_KP = (size_t)M * DM, O_VP = O_KP + (size_t)MP * FW, O_LFP = O_VP + (size_t)MP * FW, O_SP = O_LFP + (size_t)MP * FH,
                 O_KS = O_SP + (size_t)BP * HH * HK * HK, O_VS = O_KS + (size_t)MS * FW, O_LFS = O_VS + (size_t)MS * FW, O_SS = O_LFS + (size_t)MS * FH,
                 O_END = O_SS + (size_t)BS * HH * HK * HK;
constexpr size_t MiB = 1u << 20;
constexpr size_t WS_CTL = 0, CTL_ZERO_BYTES = 1 * MiB;
constexpr size_t WS_MOD = 1 * MiB, WS_WIN = 5 * MiB, WS_WBH = 16 * MiB, WS_WBF = 17 * MiB, WS_WOUT = 18 * MiB, WS_WUP = 20 * MiB, WS_WDN = 28 * MiB;
constexpr size_t WS_H = 36 * MiB, WS_QH = 70 * MiB, WS_VH = 87 * MiB, WS_SG = 104 * MiB, WS_QF = 121 * MiB, WS_KF = 138 * MiB, WS_VF = 155 * MiB;
constexpr size_t WS_G2 = 172 * MiB, WS_MG = 206 * MiB, WS_OF = 274 * MiB, WS_OH = 291 * MiB, WS_T1 = 308 * MiB, WS_MRG = 376 * MiB, WS_Y = 410 * MiB;
constexpr size_t WS_ACT = 478 * MiB, WS_U2 = 614 * MiB, WS_HG = 682 * MiB, WS_END = 832 * MiB;
static_assert((size_t)M * DM * 2 <= 34 * MiB && (size_t)M * HW * 2 <= 17 * MiB && (size_t)M * DFF * 2 <= 136 * MiB && (size_t)NPROJ * DM * 2 <= 11 * MiB, "ws map");
constexpr int CW_TMO = 0, CW_CODE = 1, CW_BAR = 4096;

constexpr int RING_OFF = 0, RING_BYTES = 131072;
constexpr int LDSCTL_OFF = RING_BYTES, MISC_OFF = LDSCTL_OFF + 320;
constexpr int LDS_BYTES = 147456;

struct Frame {
    LAS unsigned char* lds; char* ldsg; volatile LAS unsigned* MISC; gu32* ctl; int tid, lane, wave, vcu, G;
    const float *xp, *xs, *cp, *cs, *ck, *cv, *clf, *st0; const int* pt;
    const float *ada_w, *ada_b, *n1pre, *n1post, *n2pre, *n2post, *w_in, *lbw, *onorm, *fxb, *w_brh, *w_brf, *w_out, *w_up, *w_dn;
    float* out; unsigned char* ws;
    bf16 *Win_t, *Wbh_t, *Wbf_t, *Wout_t, *Wup_t, *Wdn_t, *H, *QH, *VH, *SG, *QF, *KF, *VF, *MG, *OF, *OH, *MRG, *ACT;
    float *MOD, *G2, *T1, *Y, *U2; bf16* ws_qd; float* ws_oloc;
};
__device__ __forceinline__ float wave_sum(float v) {
#pragma unroll
    for (int o = 1; o < 64; o <<= 1) v += __shfl_xor(v, o);
    return v;
}
__device__ __forceinline__ float bf2f(bf16 b) { return __uint_as_float((unsigned)b << 16); }
__device__ __forceinline__ float sigmoidf_(float x) { return __frcp_rn(1.0f + __expf(-x)); }
__device__ __forceinline__ const float* xrow(const Frame& F, int m) { return m < MP ? F.xp + (size_t)m * DM : F.xs + (size_t)(m - MP) * DM; }
__device__ __forceinline__ int modrow(int m) { return m < MP ? (m >> 11) : BP + ((m - MP) >> 3); }
__device__ __forceinline__ float* kout(const Frame& F, int m) { return m < MP ? F.out + O_KP + (size_t)m * FW : F.out + O_KS + (size_t)(m - MP) * FW; }
__device__ __forceinline__ float* vout(const Frame& F, int m) { return m < MP ? F.out + O_VP + (size_t)m * FW : F.out + O_VS + (size_t)(m - MP) * FW; }
__device__ __forceinline__ float* lfout(const Frame& F, int m) { return m < MP ? F.out + O_LFP + (size_t)m * FH : F.out + O_LFS + (size_t)(m - MP) * FH; }

__device__ __forceinline__ void tr_item(const float* W, int ldw, int K, int src_c0, bf16* WT, int dst_r0, LAS float* scr, int kb, int lane) {
    const int k0 = 64 * kb;
#pragma unroll 8
    for (int i = 0; i < 32; ++i) { const int kk = 2 * i + (lane >> 5); scr[kk * 33 + (lane & 31)] = W[(size_t)(k0 + kk) * ldw + src_c0 + (lane & 31)]; }
    LDS_WAIT(); asm volatile("" ::: "memory");
    const int c = lane & 7;
#pragma unroll
    for (int j = 0; j < 4; ++j) { const int n = (lane >> 3) + 8 * j; const LAS float* s = scr + (8 * c) * 33 + n;
        v4u o; o.x = pk2(s[0 * 33], s[1 * 33]); o.y = pk2(s[2 * 33], s[3 * 33]); o.z = pk2(s[4 * 33], s[5 * 33]); o.w = pk2(s[6 * 33], s[7 * 33]);
        *(GAS v4u*)(WT + (size_t)(dst_r0 + n) * K + k0 + 8 * c) = o; }
    LDS_WAIT(); asm volatile("" ::: "memory");
}
__device__ __forceinline__ float siluf_(float x) { return x * sigmoidf_(x); }
__device__ __forceinline__ void mod_task(Frame& F, int tsk) {
    const int lane = F.lane, w = F.wave, g = lane >> 4, n16 = lane & 15;
    const int ntile = 2 * tsk + (w >> 2), kq = w & 3, col = 16 * ntile + n16;
    f32x4 acc[9];
#pragma unroll
    for (int r = 0; r < 9; ++r) acc[r] = (f32x4){0.f, 0.f, 0.f, 0.f};
    for (int ks = 0; ks < 8; ++ks) {
        const int k0 = 256 * kq + 32 * ks + 8 * g;
        bf16x8 bfr;
#pragma unroll
        for (int j = 0; j < 8; ++j) bfr[j] = (short)f2bf(F.ada_w[(size_t)(k0 + j) * NMOD + col]);
#pragma unroll
        for (int rt = 0; rt < 9; ++rt) {
            const int row = 16 * rt + n16; bf16x8 afr = (bf16x8){0, 0, 0, 0, 0, 0, 0, 0};
            if (row < NMODR) { const float* c = (row < BP ? F.cp + (size_t)row * DM : F.cs + (size_t)(row - BP) * DM) + k0;
                const f32x4 c0 = *(const f32x4*)c, c1 = *(const f32x4*)(c + 4);
                afr[0] = (short)f2bf(siluf_(c0.x)); afr[1] = (short)f2bf(siluf_(c0.y)); afr[2] = (short)f2bf(siluf_(c0.z)); afr[3] = (short)f2bf(siluf_(c0.w));
                afr[4] = (short)f2bf(siluf_(c1.x)); afr[5] = (short)f2bf(siluf_(c1.y)); afr[6] = (short)f2bf(siluf_(c1.z)); afr[7] = (short)f2bf(siluf_(c1.w)); }
            acc[rt] = __builtin_amdgcn_mfma_f32_16x16x32_bf16(afr, bfr, acc[rt], 0, 0, 0);
        }
    }
    LAS f32x4* red = (LAS f32x4*)(F.lds + RING_OFF);
#pragma unroll
    for (int rt = 0; rt < 9; ++rt) red[(w * 9 + rt) * 64 + lane] = acc[rt];
    __syncthreads();
    if (kq == 0) {
        const float bias = F.ada_b[col];
#pragma unroll
        for (int rt = 0; rt < 9; ++rt) {
            f32x4 s = red[(w * 9 + rt) * 64 + lane] + red[((w + 1) * 9 + rt) * 64 + lane] + red[((w + 2) * 9 + rt) * 64 + lane] + red[((w + 3) * 9 + rt) * 64 + lane];
#pragma unroll
            for (int i = 0; i < 4; ++i) { const int row = 16 * rt + 4 * g + i; if (row < NMODR) F.MOD[(size_t)row * NMOD + col] = s[i] + bias; }
        }
    }
    __syncthreads();
}
__device__ __forceinline__ void p0_prologue(Frame& F) {
    for (int t = blockIdx.x; t < NMOD / 32; t += F.G) mod_task(F, t);
    LAS float* scr = (LAS float*)(F.lds + RING_OFF + F.wave * 16384);
    const int gw = F.vcu * NWAVES + F.wave, NGW = F.G * NWAVES;
    constexpr int I0 = 16 * 112, I1 = 16 * 64, I2 = 8 * 32, I3 = 8 * 32, I4 = 16 * 32, I5 = 16 * 128, I6 = 64 * 32;
    constexpr int NITEMS = I0 + I1 + I2 + I3 + I4 + I5 + I6;
    for (int it = gw; it < NITEMS; it += NGW) {
        int r = it;
        if (r < I0) { tr_item(F.w_in, INC, DM, 32 * (r % 112), F.Win_t, 32 * (r % 112), scr, r / 112, F.lane); continue; } r -= I0;
        if (r < I1) { tr_item(F.w_in, INC, DM, 3592 + 32 * (r % 64), F.Win_t, 3584 + 32 * (r % 64), scr, r / 64, F.lane); continue; } r -= I1;
        if (r < I2) { tr_item(F.w_brh, DM, HW, 32 * (r % 32), F.Wbh_t, 32 * (r % 32), scr, r / 32, F.lane); continue; } r -= I2;
        if (r < I3) { tr_item(F.w_brf, DM, FW, 32 * (r % 32), F.Wbf_t, 32 * (r % 32), scr, r / 32, F.lane); continue; } r -= I3;
        if (r < I4) { tr_item(F.w_out, DM, DM, 32 * (r % 32), F.Wout_t, 32 * (r % 32), scr, r / 32, F.lane); continue; } r -= I4;
        if (r < I5) { tr_item(F.w_up, DFF, DM, 32 * (r % 128), F.Wup_t, 32 * (r % 128), scr, r / 128, F.lane); continue; } r -= I5;
        tr_item(F.w_dn, DM, DFF, 32 * (r % 32), F.Wdn_t, 32 * (r % 32), scr, r / 32, F.lane);
    }
}

__device__ __forceinline__ void p1_norm1(Frame& F) {
    const int gw = F.vcu * NWAVES + F.wave, NGW = F.G * NWAVES, lane = F.lane;
    float wff[4][4][8];
#pragma unroll
    for (int j = 0; j < 4; ++j)
#pragma unroll
        for (int e = 0; e < 4; ++e) { const float* p = F.w_in + (size_t)(4 * lane + 256 * j + e) * INC + 3584; const f32x4 a = *(const f32x4*)p, b = *(const f32x4*)(p + 4);
            wff[j][e][0] = a.x; wff[j][e][1] = a.y; wff[j][e][2] = a.z; wff[j][e][3] = a.w; wff[j][e][4] = b.x; wff[j][e][5] = b.y; wff[j][e][6] = b.z; wff[j][e][7] = b.w; }
    f32x4 wn[4];
#pragma unroll
    for (int j = 0; j < 4; ++j) wn[j] = *(const f32x4*)(F.n1pre + 4 * lane + 256 * j);
    for (int m = gw; m < M; m += NGW) {
        const f32x4* xr = (const f32x4*)xrow(F, m) + lane; const float* mod = F.MOD + (size_t)modrow(m) * NMOD;
        f32x4 v[4]; float ss = 0.f;
#pragma unroll
        for (int j = 0; j < 4; ++j) { v[j] = xr[64 * j]; ss += (v[j].x * v[j].x + v[j].y * v[j].y) + (v[j].z * v[j].z + v[j].w * v[j].w); }
        const float rinv = 1.0f / sqrtf(wave_sum(ss) * (1.f / DM) + RMS_EPS);
        float ff[8];
#pragma unroll
        for (int q = 0; q < 8; ++q) ff[q] = 0.f;
        unsigned long long* o8 = (unsigned long long*)(F.H + (size_t)m * DM) + lane;
#pragma unroll
        for (int j = 0; j < 4; ++j) {
            const f32x4 sh = *(const f32x4*)(mod + 4 * lane + 256 * j), sc = *(const f32x4*)(mod + DM + 4 * lane + 256 * j);
            const f32x4 h = v[j] * rinv * wn[j] * (sc + 1.0f) + sh;
            o8[64 * j] = (unsigned long long)pk2(h.x, h.y) | ((unsigned long long)pk2(h.z, h.w) << 32);
#pragma unroll
            for (int q = 0; q < 8; ++q) ff[q] += (h.x * wff[j][0][q] + h.y * wff[j][1][q]) + (h.z * wff[j][2][q] + h.w * wff[j][3][q]);
        }
#pragma unroll
        for (int q = 0; q < 8; ++q) ff[q] = wave_sum(ff[q]);
        float z = ff[0];
#pragma unroll
        for (int q = 1; q < 8; ++q) z = (lane == q) ? ff[q] : z;
        if (lane < 8) { z += F.fxb[lane]; lfout(F, m)[lane] = fminf(z, 0.f) - log1pf(expf(-fabsf(z))); }
    }
}

typedef unsigned u32x4_t __attribute__((ext_vector_type(4)));
__device__ __forceinline__ u32x4_t pack8(const f32x4& a, const f32x4& b) { u32x4_t w; w.x = pg8::cvt_pk_bf16(a[0], a[1]); w.y = pg8::cvt_pk_bf16(a[2], a[3]); w.z = pg8::cvt_pk_bf16(b[0], b[1]); w.w = pg8::cvt_pk_bf16(b[2], b[3]); return w; }
__device__ __forceinline__ void unpack8(const u32x4_t w, f32x4& a, f32x4& b) {
    a[0] = __uint_as_float(w.x << 16); a[1] = __uint_as_float(w.x & 0xffff0000u); a[2] = __uint_as_float(w.y << 16); a[3] = __uint_as_float(w.y & 0xffff0000u);
    b[0] = __uint_as_float(w.z << 16); b[1] = __uint_as_float(w.z & 0xffff0000u); b[2] = __uint_as_float(w.w << 16); b[3] = __uint_as_float(w.w & 0xffff0000u); }

__device__ __forceinline__ f32x4 sig4(const f32x4 v) { return (f32x4){sigmoidf_(v[0]), sigmoidf_(v[1]), sigmoidf_(v[2]), sigmoidf_(v[3])}; }
__device__ __forceinline__ f32x4 silu4(const f32x4 v) { return v * sig4(v); }
__device__ __forceinline__ f32x4 relu2_4(const f32x4 v) { const f32x4 r = (f32x4){fmaxf(v[0], 0.f), fmaxf(v[1], 0.f), fmaxf(v[2], 0.f), fmaxf(v[3], 0.f)}; return r * r; }
__device__ __forceinline__ f32x4 g2_4(const f32x4 x, const f32x4 l0, const f32x4 l1) { f32x4 r;
    _Pragma("unroll") for (int e = 0; e < 4; ++e) { const float lb = __frcp_rn(1.0f + __expf(l1[e] - l0[e])); r[e] = __log2f(lb + (1.0f - lb) * sigmoidf_(x[e])); } return r; }
#define EPI_FOREACH(...) \
    const int row0_ = u.pm * pg8::BM + wr * 64 + fr, colb_ = u.pn * pg8::BM + wc * 32 + 8 * fq; \
    _Pragma("unroll") for (int ai = 0; ai < 2; ++ai) _Pragma("unroll") for (int m = 0; m < 4; ++m) { const int row = row0_ + ai * pg8::HALF + m * 16; \
        _Pragma("unroll") for (int bj = 0; bj < 2; ++bj) { const int col = colb_ + bj * pg8::HALF; f32x4 v0 = acc[ai][bj][m][0], v1 = acc[ai][bj][m][1]; __VA_ARGS__ } }

struct EpiProj {
    static constexpr bool PERM = true, AFTER_DRAIN = false;
    bf16 *QH, *VH, *SG, *QF, *KF, *VF, *MG; float* G2; float* out; const float* lbw;
    __device__ __forceinline__ void operator()(const f32x4 (&acc)[2][2][4][2], const pg8::Unit& u, int wr, int wc, int fr, int fq) const {
        const int seg = u.pn >> 1;
        if (u.pn >= 14) { EPI_FOREACH( *(u32x4_t*)(MG + (size_t)row * 2048 + (col - 3584)) = pack8(sig4(v0), sig4(v1)); ) }
        else if (seg == 0) { EPI_FOREACH( *(u32x4_t*)(QH + (size_t)row * HW + col) = pack8(v0 * HQ_SCALE, v1 * HQ_SCALE); ) }
        else if (seg == 1) {
            EPI_FOREACH( const int k = col - 512;
                *(f32x4*)(G2 + (size_t)row * HW + k) = g2_4(v0, *(const f32x4*)(lbw + k), *(const f32x4*)(lbw + HW + k));
                *(f32x4*)(G2 + (size_t)row * HW + k + 4) = g2_4(v1, *(const f32x4*)(lbw + k + 4), *(const f32x4*)(lbw + HW + k + 4)); ) }
        else if (seg == 2) { EPI_FOREACH( *(u32x4_t*)(VH + (size_t)row * HW + (col - 1024)) = pack8(v0, v1); ) }
        else if (seg == 3) { EPI_FOREACH( *(u32x4_t*)(SG + (size_t)row * HW + (col - 1536)) = pack8(silu4(v0), silu4(v1)); ) }
        else if (seg == 4) { EPI_FOREACH( *(u32x4_t*)(QF + (size_t)row * FW + (col - 2048)) = pack8(v0 * C2, v1 * C2); ) }
        else if (seg == 5) { EPI_FOREACH( const int c = col - 2560; *(u32x4_t*)(KF + (size_t)row * FW + c) = pack8(v0, v1);
                float* o = (row < MP ? out + O_KP + (size_t)row * FW : out + O_KS + (size_t)(row - MP) * FW) + c; *(f32x4*)o = v0; *(f32x4*)(o + 4) = v1; ) }
        else { EPI_FOREACH( const int c = col - 3072; *(u32x4_t*)(VF + (size_t)row * FW + c) = pack8(v0, v1);
                float* o = (row < MP ? out + O_VP + (size_t)row * FW : out + O_VS + (size_t)(row - MP) * FW) + c; *(f32x4*)o = v0; *(f32x4*)(o + 4) = v1; ) }
    }
};
struct EpiBrH {
    static constexpr bool PERM = true, AFTER_DRAIN = false; const bf16* MG; float* T1;
    __device__ __forceinline__ void operator()(const f32x4 (&acc)[2][2][4][2], const pg8::Unit& u, int wr, int wc, int fr, int fq) const {
        EPI_FOREACH( f32x4 ga, gb; unpack8(*(const u32x4_t*)(MG + (size_t)row * 2048 + col), ga, gb); *(f32x4*)(T1 + (size_t)row * DM + col) = v0 * ga; *(f32x4*)(T1 + (size_t)row * DM + col + 4) = v1 * gb; ) }
};
struct EpiBrF {
    static constexpr bool PERM = true, AFTER_DRAIN = false; const bf16* MG; const float* T1; bf16* MRG;
    __device__ __forceinline__ void operator()(const f32x4 (&acc)[2][2][4][2], const pg8::Unit& u, int wr, int wc, int fr, int fq) const {
        EPI_FOREACH( f32x4 ga, gb; unpack8(*(const u32x4_t*)(MG + (size_t)row * 2048 + DM + col), ga, gb);
            const f32x4 t0 = *(const f32x4*)(T1 + (size_t)row * DM + col), t1 = *(const f32x4*)(T1 + (size_t)row * DM + col + 4);
            *(u32x4_t*)(MRG + (size_t)row * DM + col) = pack8(t0 + v0 * ga, t1 + v1 * gb); ) }
};
struct EpiF32 {
    static constexpr bool PERM = true, AFTER_DRAIN = false; float* O; int ldc;
    __device__ __forceinline__ void operator()(const f32x4 (&acc)[2][2][4][2], const pg8::Unit& u, int wr, int wc, int fr, int fq) const {
        EPI_FOREACH( *(f32x4*)(O + (size_t)row * ldc + col) = v0; *(f32x4*)(O + (size_t)row * ldc + col + 4) = v1; ) }
};
struct EpiRelu2 {
    static constexpr bool PERM = true, AFTER_DRAIN = false; bf16* O; int ldc;
    __device__ __forceinline__ void operator()(const f32x4 (&acc)[2][2][4][2], const pg8::Unit& u, int wr, int wc, int fr, int fq) const {
        EPI_FOREACH( *(u32x4_t*)(O + (size_t)row * ldc + col) = pack8(relu2_4(v0), relu2_4(v1)); ) }
};

__device__ __forceinline__ void p8_midnorm(Frame& F) {
    const int gw = F.vcu * NWAVES + F.wave, NGW = F.G * NWAVES, lane = F.lane;
    f32x4 wpost[4], wpre[4];
#pragma unroll
    for (int j = 0; j < 4; ++j) { wpost[j] = *(const f32x4*)(F.n1post + 4 * lane + 256 * j); wpre[j] = *(const f32x4*)(F.n2pre + 4 * lane + 256 * j); }
    for (int m = gw; m < M; m += NGW) {
        const f32x4* xr = (const f32x4*)xrow(F, m) + lane; const f32x4* yr = (const f32x4*)(F.Y + (size_t)m * DM) + lane; const float* mod = F.MOD + (size_t)modrow(m) * NMOD;
        f32x4 y[4], x1[4]; float ss = 0.f;
#pragma unroll
        for (int j = 0; j < 4; ++j) { y[j] = yr[64 * j]; ss += (y[j].x * y[j].x + y[j].y * y[j].y) + (y[j].z * y[j].z + y[j].w * y[j].w); }
        const float rinv = 1.0f / sqrtf(wave_sum(ss) * (1.f / DM) + RMS_EPS);
        float s2 = 0.f; f32x4* o4 = (f32x4*)(F.out + O_Y + (size_t)m * DM) + lane;
#pragma unroll
        for (int j = 0; j < 4; ++j) { const f32x4 gt = *(const f32x4*)(mod + 2 * DM + 4 * lane + 256 * j);
            x1[j] = xr[64 * j] + gt * (y[j] * rinv * wpost[j]); o4[64 * j] = x1[j];
            s2 += (x1[j].x * x1[j].x + x1[j].y * x1[j].y) + (x1[j].z * x1[j].z + x1[j].w * x1[j].w); }
        const float r2 = 1.0f / sqrtf(wave_sum(s2) * (1.f / DM) + RMS_EPS);
        unsigned long long* o8 = (unsigned long long*)(F.H + (size_t)m * DM) + lane;
#pragma unroll
        for (int j = 0; j < 4; ++j) { const f32x4 sh = *(const f32x4*)(mod + 3 * DM + 4 * lane + 256 * j), sc = *(const f32x4*)(mod + 4 * DM + 4 * lane + 256 * j);
            const f32x4 h = x1[j] * r2 * wpre[j] * (sc + 1.0f) + sh;
            o8[64 * j] = (unsigned long long)pk2(h.x, h.y) | ((unsigned long long)pk2(h.z, h.w) << 32); }
    }
}
__device__ __forceinline__ void p11_final(Frame& F) {
    const int gw = F.vcu * NWAVES + F.wave, NGW = F.G * NWAVES, lane = F.lane;
    f32x4 wpost[4];
#pragma unroll
    for (int j = 0; j < 4; ++j) wpost[j] = *(const f32x4*)(F.n2post + 4 * lane + 256 * j);
    for (int m = gw; m < M; m += NGW) {
        const f32x4* ur = (const f32x4*)(F.U2 + (size_t)m * DM) + lane; const float* mod = F.MOD + (size_t)modrow(m) * NMOD;
        f32x4 uu[4]; float ss = 0.f;
#pragma unroll
        for (int j = 0; j < 4; ++j) { uu[j] = ur[64 * j]; ss += (uu[j].x * uu[j].x + uu[j].y * uu[j].y) + (uu[j].z * uu[j].z + uu[j].w * uu[j].w); }
        const float rinv = 1.0f / sqrtf(wave_sum(ss) * (1.f / DM) + RMS_EPS);
        f32x4* o4 = (f32x4*)(F.out + O_Y + (size_t)m * DM) + lane;
#pragma unroll
        for (int j = 0; j < 4; ++j) { const f32x4 gt = *(const f32x4*)(mod + 5 * DM + 4 * lane + 256 * j); o4[64 * j] = o4[64 * j] + gt * (uu[j] * rinv * wpost[j]); }
    }
}
#include <hip/hip_bf16.h>
#include <cmath>
namespace attn_body {
using bf16=__hip_bfloat16;
using bf16x8=__attribute__((ext_vector_type(8)))short;
using s16x4=__attribute__((ext_vector_type(4)))short;
using f32x16=__attribute__((ext_vector_type(16)))float;
using u32x4=__attribute__((ext_vector_type(4)))unsigned;
constexpr int BATCH=8,NHEAD=8,SEQ=2048,D=64,DM=NHEAD*D;
constexpr int NW=8,QBLK=32,QB=QBLK*NW,KVBLK=64,NQB=SEQ/QB;
constexpr int ATTN_PITCH=DM, ATTN_UNIT_ROWS=QB;
__device__ __forceinline__ int crow(int r,int hi){return (r&3)+8*(r>>2)+4*hi;}
#define SBAR() __builtin_amdgcn_sched_barrier(0)
__device__ __forceinline__ void cmask(f32x16&p0,f32x16&p1,int jb,int qrel,int hi){
  const float NEG=-INFINITY; const int thr=qrel-64*jb-4*hi;
  #pragma unroll
  for(int r=0;r<16;++r){const int c=(r&3)+8*(r>>2); if(c>thr)p0[r]=NEG; if(c+32>thr)p1[r]=NEG;}
}
constexpr int NSLOT=3, SLOTB=8192;
constexpr int LDS_K=0, LDS_V=NSLOT*SLOTB, LDS_WS=2*NSLOT*SLOTB, LDS_OST=LDS_WS+NW*64*4, LDS_BIAS=LDS_OST+NW*4096, LDS_BYTES=LDS_BIAS+SEQ*4;
constexpr float C2=0.125f*1.4426950408889634f;
__device__ __forceinline__ void glds16(const void*gsrc,unsigned lds_dst){unsigned keep;
  asm volatile("s_mov_b32 %0, m0\n\ts_mov_b32 m0, %2\n\ts_nop 0\n\tglobal_load_lds_dwordx4 %1, off\n\ts_mov_b32 m0, %0":"=&s"(keep):"v"(gsrc),"s"(lds_dst):"memory");}
__device__ __forceinline__ float max3f(float a,float b,float c){float r;asm("v_max3_f32 %0, %1, %2, %3":"=v"(r):"v"(a),"v"(b),"v"(c));return r;}
__device__ __forceinline__ float max2f(float a,float b){float r;asm("v_max_f32_e32 %0, %1, %2":"=v"(r):"v"(a),"v"(b));return r;}
__device__ __forceinline__ float fadd_s(float a,float b){float r;asm("v_add_f32_e32 %0, %1, %2":"=v"(r):"v"(a),"v"(b));return r;}
__device__ __forceinline__ float fsub_s(float a,float b){float r;asm("v_sub_f32_e32 %0, %1, %2":"=v"(r):"v"(a),"v"(b));return r;}
typedef float fx4 __attribute__((ext_vector_type(4))); typedef float f32x2_t __attribute__((ext_vector_type(2))); typedef __bf16 bf16x2_t __attribute__((ext_vector_type(2)));
__device__ __forceinline__ unsigned cvtpk_s(float lo,float hi){f32x2_t v={lo,hi};bf16x2_t b=__builtin_convertvector(v,bf16x2_t);return __builtin_bit_cast(unsigned,b);}
#define WAIT_BAR(N) asm volatile("s_waitcnt vmcnt(" #N ") lgkmcnt(0)\n\ts_barrier":::"memory")

__device__ __forceinline__ void qkt(f32x16&p0,f32x16&p1,const char*Kslot,const bf16x8*qr,int r32,int hi){
  const char*kb=Kslot+hi*1024+r32*16;
  #pragma unroll
  for(int d0=0;d0<4;++d0){
    const bf16x8 b0=*reinterpret_cast<const bf16x8*>(kb+d0*2048);
    const bf16x8 b1=*reinterpret_cast<const bf16x8*>(kb+d0*2048+512);
    if(d0==0){p0=__builtin_amdgcn_mfma_f32_32x32x16_bf16(b0,qr[0],p0,0,0,0);p1=__builtin_amdgcn_mfma_f32_32x32x16_bf16(b1,qr[0],p1,0,0,0);}
    else{p0=__builtin_amdgcn_mfma_f32_32x32x16_bf16(b0,qr[d0],p0,0,0,0);p1=__builtin_amdgcn_mfma_f32_32x32x16_bf16(b1,qr[d0],p1,0,0,0);}}
}
typedef __attribute__((address_space(3))) const char* lds_cptr;
typedef short v4i16_t __attribute__((ext_vector_type(4)));
__device__ __forceinline__ void kload8(bf16x8*kf,lds_cptr kp){
  kf[0]=*(const __attribute__((address_space(3))) bf16x8*)(kp);      kf[1]=*(const __attribute__((address_space(3))) bf16x8*)(kp+512);
  kf[2]=*(const __attribute__((address_space(3))) bf16x8*)(kp+2048); kf[3]=*(const __attribute__((address_space(3))) bf16x8*)(kp+2560);
  kf[4]=*(const __attribute__((address_space(3))) bf16x8*)(kp+4096); kf[5]=*(const __attribute__((address_space(3))) bf16x8*)(kp+4608);
  kf[6]=*(const __attribute__((address_space(3))) bf16x8*)(kp+6144); kf[7]=*(const __attribute__((address_space(3))) bf16x8*)(kp+6656);
}
__device__ __forceinline__ void kload2(bf16x8*kf,lds_cptr kp,int j){ kf[2*j]=*(const __attribute__((address_space(3))) bf16x8*)(kp+j*2048); kf[2*j+1]=*(const __attribute__((address_space(3))) bf16x8*)(kp+j*2048+512); }
__device__ __forceinline__ s16x4 vtr(lds_cptr p){ return __builtin_bit_cast(s16x4,__builtin_amdgcn_ds_read_tr16_b64_v4i16((__attribute__((address_space(3))) v4i16_t*)p)); }
__device__ __forceinline__ float rowmax(const f32x16&p0,const f32x16&p1){
  float a=max3f(p0[0],p0[1],p1[0]),b=max3f(p0[2],p0[3],p1[1]);a=max3f(a,p1[2],p1[3]);
  #pragma unroll
  for(int r=4;r<16;r+=4){a=max3f(a,p0[r],p0[r+1]);b=max3f(b,p0[r+2],p0[r+3]);a=max3f(a,p1[r],p1[r+1]);b=max3f(b,p1[r+2],p1[r+3]);}
  const float m=max2f(a,b);
  auto rr=__builtin_amdgcn_permlane32_swap(__float_as_uint(m),__float_as_uint(m),false,false);
  return max2f(__uint_as_float(rr[0]),__uint_as_float(rr[1]));
}
__device__ __forceinline__ void pv(f32x16*o,int vb,bf16x8 pa0,bf16x8 pa1,bf16x8 pa2,bf16x8 pa3){
  #pragma unroll
  for(int d0=0;d0<2;++d0){s16x4 lo[4],hi[4];
    #pragma unroll
    for(int ks=0;ks<4;++ks){
      asm volatile("ds_read_b64_tr_b16 %0,%1 offset:%c2":"=&v"(lo[ks]):"v"(vb),"i"(d0*4096+ks*1024):"memory");
      asm volatile("ds_read_b64_tr_b16 %0,%1 offset:%c2":"=&v"(hi[ks]):"v"(vb),"i"(d0*4096+ks*1024+512):"memory");}
    asm volatile("s_waitcnt lgkmcnt(0)":::"memory");SBAR();
    #define PK(k) (bf16x8){lo[k][0],lo[k][1],lo[k][2],lo[k][3],hi[k][0],hi[k][1],hi[k][2],hi[k][3]}
    o[d0]=__builtin_amdgcn_mfma_f32_32x32x16_bf16(pa0,PK(0),o[d0],0,0,0);
    o[d0]=__builtin_amdgcn_mfma_f32_32x32x16_bf16(pa1,PK(1),o[d0],0,0,0);
    o[d0]=__builtin_amdgcn_mfma_f32_32x32x16_bf16(pa2,PK(2),o[d0],0,0,0);
    o[d0]=__builtin_amdgcn_mfma_f32_32x32x16_bf16(pa3,PK(3),o[d0],0,0,0);
    #undef PK
  }
}

#ifndef ATTN_STORE16
#define ATTN_STORE16(p,v) (*(u32x4*)(p)=(v))
#endif
template<int THRL> __device__ __forceinline__ void attn_unit(int b,int h,int qb,const bf16*Q,const bf16*__restrict__ K,const bf16*__restrict__ V,bf16*O,char*shm){
  const int tid=threadIdx.x,lane=tid&63,r32=lane&31,hi=lane>>5; const int wid=__builtin_amdgcn_readfirstlane(tid>>6);
  const long rowbase=(long)b*SEQ; const int q0=qb*QB;
  const bf16*Qw=Q+(rowbase+q0+wid*QBLK)*DM+h*D;
  const bf16*Kh=K+rowbase*DM+h*D,*Vh=V+rowbase*DM+h*D;
  const unsigned lds0=(unsigned)(uintptr_t)shm;
  float*wsf=(float*)(shm+LDS_WS)+wid*64;
  const bf16*ksrc=Kh+(long)lane*DM+wid*8;
  const bf16*vsrc=Vh+(long)(16*(wid&3)+(lane>>2))*DM+(wid>>2)*32+(lane&3)*8;
  const unsigned kdst=lds0+LDS_K+wid*1024, vdst=lds0+LDS_V+wid*1024;
  #define DMA_K(t,slot) glds16(ksrc+(long)(t)*KVBLK*DM,(unsigned)__builtin_amdgcn_readfirstlane(kdst+(slot)))
  #define DMA_V(t,slot) glds16(vsrc+(long)(t)*KVBLK*DM,(unsigned)__builtin_amdgcn_readfirstlane(vdst+(slot)))
  const int vb0=(int)(lds0+LDS_V)+((lane>>4)&1)*32+(lane&3)*8+(4*hi+((lane&15)>>2))*64;
  const char*Kbase=shm+LDS_K; bf16x8 kf[8];
  const lds_cptr shm3=(lds_cptr)shm; const lds_cptr kp0=shm3+LDS_K+hi*1024+r32*16; const lds_cptr vp0=shm3+LDS_V+((lane>>4)&1)*32+(lane&3)*8+(4*hi+((lane&15)>>2))*64;
  const int NT=(q0+QB)/KVBLK;
  DMA_K(0,0);DMA_V(0,0);DMA_K(1,SLOTB);
  bf16x8 qr[4];
  #pragma unroll
  for(int d0=0;d0<4;++d0)qr[d0]=*reinterpret_cast<const bf16x8*>(&Qw[(long)r32*DM+d0*16+hi*8]);
  float mhat=0.f,l_reg=0.f;f32x16 o[2];o[0]=f32x16{};o[1]=f32x16{};
  const int qrel=wid*QBLK+r32;
  #define CMASK(P0,P1,t) do{int jb_=(t)-(NT-4); if(jb_>=0)cmask(P0,P1,jb_,qrel,hi);}while(0)
  const __attribute__((address_space(3))) float* biasp=(const __attribute__((address_space(3))) float*)(shm3+LDS_BIAS)+4*hi;
  #define INITC(P0,P1,t) do{ const __attribute__((address_space(3))) float* bp_=biasp+64*(t); \
    _Pragma("unroll") for(int g_=0;g_<4;++g_){ const fx4 b0_=*(const __attribute__((address_space(3))) fx4*)(bp_+8*g_); \
      _Pragma("unroll") for(int e_=0;e_<4;++e_) P0[4*g_+e_]=b0_[e_]-mhat; } \
    _Pragma("unroll") for(int g_=0;g_<4;++g_){ const fx4 b1_=*(const __attribute__((address_space(3))) fx4*)(bp_+32+8*g_); \
      _Pragma("unroll") for(int e_=0;e_<4;++e_) P1[4*g_+e_]=b1_[e_]-mhat; } }while(0)
  bool resc=false;
  #define START(P0,P1) do{ const float rm=rowmax(P0,P1); resc=false; \
    { const float dl=rm; mhat=fadd_s(mhat,dl); \
      _Pragma("unroll") for(int r=0;r<16;++r){P0[r]=fsub_s(P0[r],dl);P1[r]=fsub_s(P1[r],dl);} \
      } \
    _Pragma("unroll") for(int r=0;r<16;++r)P0[r]=__builtin_amdgcn_exp2f(P0[r]); }while(0)
  #define RESC() do{ if(resc){ asm volatile("s_waitcnt lgkmcnt(0)":::"memory"); \
      _Pragma("unroll") for(int d_=0;d_<2;++d_) _Pragma("unroll") for(int r=0;r<16;++r)o[d_][r]*=wsf[crow(r,hi)]; } }while(0)
  f32x16 pA0,pA1,pB0,pB1;
  int sl_prev=0,sl_cur=0,sl_next=SLOTB;
  #define ROT() do{sl_prev=sl_cur;sl_cur=sl_next;sl_next=(sl_next==(NSLOT-1)*SLOTB)?0:sl_next+SLOTB;}while(0)
  DMA_K(2,2*SLOTB);
  WAIT_BAR(3);
  INITC(pA0,pA1,0);qkt(pA0,pA1,Kbase,qr,r32,hi);asm volatile("s_nop 15\n\ts_nop 7":"+v"(pA0),"+v"(pA1));CMASK(pA0,pA1,0);
  START(pA0,pA1);
  _Pragma("unroll") for(int r=0;r<16;++r)pA1[r]=__builtin_amdgcn_exp2f(pA1[r]);
  WAIT_BAR(0);
  DMA_K(3,0);DMA_V(1,SLOTB);
  ROT();
  kload8(kf,kp0+sl_cur);
  WAIT_BAR(2);
  s16x4 vlo[8],vhi[8]; u32x4 pw0,pw1,pw2,pw3;
  #define PKW(P,B) cvtpk_s(P[B],P[B+1])
  #define PAF(k) __builtin_bit_cast(bf16x8,pw##k)
  #define VFR(i) (bf16x8){vlo[i][0],vlo[i][1],vlo[i][2],vlo[i][3],vhi[i][0],vhi[i][1],vhi[i][2],vhi[i][3]}
  #define PIN(x) asm volatile("":"+v"(x))
  #define MX3(a,b,c) __builtin_fmaxf(__builtin_fmaxf((a),(b)),(c))
  #define GAPA(MF,A0,A1,A2,A3,W0,W1,PW) do{ MF; sacc+=A0; sacc+=A1; sacc+=A2; sacc+=A3; PIN(sacc); W0; W1; PIN(PW); SBAR(); }while(0)
  #define EX(v) __builtin_amdgcn_exp2f(v)
  #define GAPB(MF,X,B) do{ MF; X[B]=EX(X[B]); X[B+1]=EX(X[B+1]); X[B+2]=EX(X[B+2]); X[B+3]=EX(X[B+3]); PIN(X); SBAR(); }while(0)
  #define VRD(i) do{ vlo[i]=vtr(vp_+(((i)>>2)*4096+((i)&3)*1024)); vhi[i]=vtr(vp_+(((i)>>2)*4096+((i)&3)*1024+512)); }while(0)
  #define KRD(G,j) do{ if(G){ kload2(kf,kp0+sl_next,j); SBAR(); } }while(0)
  #define STEP(C0,C1,P0,P1,t,GK,GV,GL) do{ SBAR(); INITC(C0,C1,t); SBAR(); \
    const lds_cptr vp_=vp0+sl_prev; \
    VRD(0); SBAR(); float sacc=(P0[0]+P0[1]); \
    GAPA(C0=__builtin_amdgcn_mfma_f32_32x32x16_bf16(kf[0],qr[0],C0,0,0,0), P0[2],P0[3],P0[4],P0[5],     pw0[0]=PKW(P0,0), pw0[1]=PKW(P0,2), pw0); \
    VRD(4); SBAR(); GAPA(C1=__builtin_amdgcn_mfma_f32_32x32x16_bf16(kf[1],qr[0],C1,0,0,0), P0[6],P0[7],P0[8],P0[9],     pw0[2]=PKW(P0,4), pw0[3]=PKW(P0,6), pw0); \
    VRD(1); SBAR(); GAPA(C0=__builtin_amdgcn_mfma_f32_32x32x16_bf16(kf[2],qr[1],C0,0,0,0),   P0[10],P0[11],P0[12],P0[13], pw1[0]=PKW(P0,8), pw1[1]=PKW(P0,10), pw1); \
    VRD(5); SBAR(); GAPA(C1=__builtin_amdgcn_mfma_f32_32x32x16_bf16(kf[3],qr[1],C1,0,0,0),   P0[14],P0[15],P1[0],P1[1],   pw1[2]=PKW(P0,12),pw1[3]=PKW(P0,14), pw1); \
    VRD(2); SBAR(); GAPA(C0=__builtin_amdgcn_mfma_f32_32x32x16_bf16(kf[4],qr[2],C0,0,0,0),   P1[2],P1[3],P1[4],P1[5],     pw2[0]=PKW(P1,0), pw2[1]=PKW(P1,2), pw2); \
    VRD(6); SBAR(); GAPA(C1=__builtin_amdgcn_mfma_f32_32x32x16_bf16(kf[5],qr[2],C1,0,0,0),   P1[6],P1[7],P1[8],P1[9],     pw2[2]=PKW(P1,4), pw2[3]=PKW(P1,6), pw2); \
    VRD(3); SBAR(); GAPA(C0=__builtin_amdgcn_mfma_f32_32x32x16_bf16(kf[6],qr[3],C0,0,0,0),   P1[10],P1[11],P1[12],P1[13], pw3[0]=PKW(P1,8), pw3[1]=PKW(P1,10), pw3); \
    VRD(7); SBAR(); GAPA(C1=__builtin_amdgcn_mfma_f32_32x32x16_bf16(kf[7],qr[3],C1,0,0,0),   P1[14],P1[15],0.f,0.f,       pw3[2]=PKW(P1,12),pw3[3]=PKW(P1,14), pw3); \
    l_reg+=sacc; \
    if(GK){DMA_K((t)+3,sl_cur);} if(GV){DMA_V((t)+1,sl_next);} \
    CMASK(C0,C1,t); \
    { float a=MX3(C0[0],C0[1],C1[0]),b=MX3(C0[2],C0[3],C1[1]); a=MX3(a,C1[2],C1[3]); \
      _Pragma("unroll") for(int r=4;r<16;r+=4){a=MX3(a,C0[r],C0[r+1]);b=MX3(b,C0[r+2],C0[r+3]);a=MX3(a,C1[r],C1[r+1]);b=MX3(b,C1[r+2],C1[r+3]);} \
      float rm=__builtin_fmaxf(a,b); { auto rr=__builtin_amdgcn_permlane32_swap(__float_as_uint(rm),__float_as_uint(rm),false,false); rm=__builtin_fmaxf(__uint_as_float(rr[0]),__uint_as_float(rr[1])); } \
      resc=false; \
      if(__builtin_expect(__any(rm>(float)THRL),0)){ const float dl=__builtin_fmaxf(rm,0.f); mhat+=dl; \
        _Pragma("unroll") for(int r=0;r<16;++r){C0[r]-=dl;C1[r]-=dl;} \
        const float f=__builtin_amdgcn_exp2f(-dl); l_reg*=f; if(hi==0)wsf[r32]=f; resc=true; } } \
    SBAR(); \
    GAPB(o[0]=__builtin_amdgcn_mfma_f32_32x32x16_bf16(PAF(0),VFR(0),o[0],0,0,0), C0,0); \
    GAPB(o[1]=__builtin_amdgcn_mfma_f32_32x32x16_bf16(PAF(0),VFR(4),o[1],0,0,0), C0,4); \
    KRD(GL,0); GAPB(o[0]=__builtin_amdgcn_mfma_f32_32x32x16_bf16(PAF(1),VFR(1),o[0],0,0,0), C0,8); \
    KRD(GL,1); GAPB(o[1]=__builtin_amdgcn_mfma_f32_32x32x16_bf16(PAF(1),VFR(5),o[1],0,0,0), C0,12); \
    KRD(GL,2); GAPB(o[0]=__builtin_amdgcn_mfma_f32_32x32x16_bf16(PAF(2),VFR(2),o[0],0,0,0), C1,0); \
    KRD(GL,3); GAPB(o[1]=__builtin_amdgcn_mfma_f32_32x32x16_bf16(PAF(2),VFR(6),o[1],0,0,0), C1,4); \
    GAPB(o[0]=__builtin_amdgcn_mfma_f32_32x32x16_bf16(PAF(3),VFR(3),o[0],0,0,0), C1,8); \
    GAPB(o[1]=__builtin_amdgcn_mfma_f32_32x32x16_bf16(PAF(3),VFR(7),o[1],0,0,0), C1,12); \
    }while(0)
  int t=1;
  #undef CMASK
  #define CMASK(P0,P1,t) do{}while(0)
  for(;t+5<NT;t+=2){
    STEP(pB0,pB1,pA0,pA1,t,true,true,true);     WAIT_BAR(2); RESC(); ROT();
    STEP(pA0,pA1,pB0,pB1,t+1,true,true,true);   WAIT_BAR(2); RESC(); ROT();
  }
  #undef CMASK
  #define CMASK(P0,P1,t) do{int jb_=(t)-(NT-4); if(jb_>=0)cmask(P0,P1,jb_,qrel,hi);}while(0)
  #define ENDW(tt) do{ if((tt)+3<NT){WAIT_BAR(2);} else if((tt)+2<NT){WAIT_BAR(1);} else {WAIT_BAR(0);} }while(0)
  for(;t+1<NT;t+=2){
    STEP(pB0,pB1,pA0,pA1,t,(t+3<NT),(t+1<NT),(t+1<NT));       ENDW(t);   RESC(); ROT();
    STEP(pA0,pA1,pB0,pB1,t+1,(t+4<NT),(t+2<NT),(t+2<NT));     ENDW(t+1); RESC(); ROT();
  }
  STEP(pB0,pB1,pA0,pA1,NT-1,false,false,false); RESC();
  { float sacc=pB0[0]+pB0[1]; _Pragma("unroll") for(int r=2;r<16;++r)sacc+=pB0[r]; _Pragma("unroll") for(int r=0;r<16;++r)sacc+=pB1[r]; l_reg+=sacc;
    pw0=(u32x4){PKW(pB0,0),PKW(pB0,2),PKW(pB0,4),PKW(pB0,6)};pw1=(u32x4){PKW(pB0,8),PKW(pB0,10),PKW(pB0,12),PKW(pB0,14)};pw2=(u32x4){PKW(pB1,0),PKW(pB1,2),PKW(pB1,4),PKW(pB1,6)};pw3=(u32x4){PKW(pB1,8),PKW(pB1,10),PKW(pB1,12),PKW(pB1,14)};
    SBAR(); pv(o,vb0+sl_cur,PAF(0),PAF(1),PAF(2),PAF(3)); }
  #undef PKW
  #undef PAF
  #undef VFR
  #undef PIN
  #undef MX3
  #undef GAPA
  #undef GAPB
  #undef EX
  #undef VRD
  #undef KRD
  #undef STEP
  #undef ENDW
  {auto rr=__builtin_amdgcn_permlane32_swap(__float_as_uint(l_reg),__float_as_uint(l_reg),false,false);l_reg=__uint_as_float(rr[0])+__uint_as_float(rr[1]);}
  if(hi==0)wsf[32+r32]=l_reg;asm volatile("s_waitcnt lgkmcnt(0)":::"memory");
  float rli[16];
  #pragma unroll
  for(int r=0;r<16;++r)rli[r]=__builtin_amdgcn_rcpf(wsf[32+crow(r,hi)]);
  bf16*Ow=O+(rowbase+q0+wid*QBLK)*DM+h*D;
  { bf16*stg=(bf16*)(shm+LDS_OST)+wid*2048;
    #pragma unroll
    for(int r=0;r<16;++r){const int orow=crow(r,hi);
      #pragma unroll
      for(int d0=0;d0<2;++d0)stg[orow*64+d0*32+r32]=__float2bfloat16(o[d0][r]*rli[r]);}
    asm volatile("s_waitcnt lgkmcnt(0)":::"memory");
    #pragma unroll
    for(int i=0;i<4;++i){const int row=i*8+(lane>>3),ch=lane&7; const u32x4 v=*(const u32x4*)(stg+row*64+ch*8); ATTN_STORE16(Ow+(long)row*DM+ch*8,v);} }
  asm volatile("s_waitcnt lgkmcnt(0)\n\ts_barrier":::"memory");
  #undef DMA_K
  #undef DMA_V
  #undef CMASK
  #undef INITC
  #undef START
  #undef RESC
  #undef ROT
}
constexpr int ATTN_LDS_BYTES=LDS_BYTES;
struct AttnTensors { const bf16* Q; const bf16* K; const bf16* V; bf16* O; };
struct AttnUnit { int bh; int qb; };
#undef SBAR
#undef WAIT_BAR
}

constexpr int SA_STRIDE = 1056;
constexpr size_t WS_SA_PM = WS_HG, WS_SA_PO = WS_HG + 1 * MiB;
typedef float f32x4u __attribute__((ext_vector_type(4), aligned(4)));
struct SaBlk { f32x4 k[2][2][2]; float v[2][4][4]; };
__device__ __forceinline__ void sa_load(SaBlk& B, const float* kbase, const float* vbase, int n16, int g) {
#pragma unroll
    for (int tau = 0; tau < 2; ++tau)
#pragma unroll
        for (int ks = 0; ks < 2; ++ks) { const float* p = kbase + (size_t)(16 * tau + n16) * 512 + 32 * ks + 8 * g;
            B.k[tau][ks][0] = __builtin_nontemporal_load((const f32x4*)p); B.k[tau][ks][1] = __builtin_nontemporal_load((const f32x4*)(p + 4)); }
#pragma unroll
    for (int tau = 0; tau < 2; ++tau)
#pragma unroll
        for (int e = 0; e < 4; ++e)
#pragma unroll
            for (int dt = 0; dt < 4; ++dt) B.v[tau][e][dt] = __builtin_nontemporal_load(vbase + (size_t)(16 * tau + 4 * g + e) * 512 + 16 * dt + n16);
}
__device__ __forceinline__ bf16x8 pk8(float a, float b, float c, float d, float e, float f, float g, float h) {
    u32x4_t w; w.x = pg8::cvt_pk_bf16(a, b); w.y = pg8::cvt_pk_bf16(c, d); w.z = pg8::cvt_pk_bf16(e, f); w.w = pg8::cvt_pk_bf16(g, h); return __builtin_bit_cast(bf16x8, w); }
struct SaState { float m, l; f32x4 o[4]; };
template <bool NEWBLK> __device__ __forceinline__ void sa_compute(SaState& S, const SaBlk& B, const bf16x8 (&qf)[2], const LAS float* biasp  , int n16, int g) {
    f32x4 x[2];
#pragma unroll
    for (int tau = 0; tau < (NEWBLK ? 1 : 2); ++tau) {
        f32x4 acc = (f32x4){0.f, 0.f, 0.f, 0.f};
#pragma unroll
        for (int ks = 0; ks < 2; ++ks) { const f32x4 lo = B.k[tau][ks][0], hi = B.k[tau][ks][1];
            acc = __builtin_amdgcn_mfma_f32_16x16x32_bf16(pk8(lo[0], lo[1], lo[2], lo[3], hi[0], hi[1], hi[2], hi[3]), qf[ks], acc, 0, 0, 0); }
        const f32x4 bb = *(const LAS f32x4*)(biasp + 16 * tau + 4 * g);
        x[tau] = acc + bb;
    }
    if (NEWBLK) {
#pragma unroll
        for (int i = 0; i < 4; ++i) { const int j = 4 * g + i; if (j > n16 || j >= TS) x[0][i] = -INFINITY; }
        x[1] = (f32x4){-INFINITY, -INFINITY, -INFINITY, -INFINITY};
    }
    const float lm = fmaxf(fmaxf(fmaxf(x[0][0], x[0][1]), fmaxf(x[0][2], x[0][3])), fmaxf(fmaxf(x[1][0], x[1][1]), fmaxf(x[1][2], x[1][3])));
    if (__any(lm > S.m + 8.0f)) {
        float rm = fmaxf(lm, __shfl_xor(lm, 16)); rm = fmaxf(rm, __shfl_xor(rm, 32));
        const float mn = fmaxf(S.m, rm), f = (S.m == -INFINITY) ? 0.f : __builtin_amdgcn_exp2f(S.m - mn);
        S.l *= f;
#pragma unroll
        for (int dt = 0; dt < 4; ++dt) S.o[dt] = S.o[dt] * f;
        S.m = mn;
    }
    float p[2][4];
#pragma unroll
    for (int tau = 0; tau < 2; ++tau)
#pragma unroll
        for (int i = 0; i < 4; ++i) { p[tau][i] = __builtin_amdgcn_exp2f(x[tau][i] - S.m); S.l += p[tau][i]; }
    const bf16x8 pf = pk8(p[0][0], p[0][1], p[0][2], p[0][3], p[1][0], p[1][1], p[1][2], p[1][3]);
#pragma unroll
    for (int dt = 0; dt < 4; ++dt) {
        const bf16x8 vf = NEWBLK ? pk8(B.v[0][0][dt], B.v[0][1][dt], B.v[0][2][dt], B.v[0][3][dt], 0.f, 0.f, 0.f, 0.f)
                                 : pk8(B.v[0][0][dt], B.v[0][1][dt], B.v[0][2][dt], B.v[0][3][dt], B.v[1][0][dt], B.v[1][1][dt], B.v[1][2][dt], B.v[1][3][dt]);
        S.o[dt] = __builtin_amdgcn_mfma_f32_16x16x32_bf16(vf, pf, S.o[dt], 0, 0, 0);
    }
}
__device__ __forceinline__ void sample_attn_unit(Frame& F, int b, int half) {
    const int lane = F.lane, h = F.wave, n16 = lane & 15, g = lane >> 4;
    LAS float* biasL = (LAS float*)(F.lds + RING_OFF) + h * SA_STRIDE;
    {
        const int s0 = 32 * lane; const int pg = F.pt[b * NPG + (s0 >> 7)]; const float* lp = F.clf + ((size_t)pg * PAGE + (s0 & 127)) * FH + h;
        float v[32];
#pragma unroll
        for (int i = 0; i < 32; ++i) v[i] = lp[(size_t)i * FH];
        float tot = 0.f;
#pragma unroll
        for (int i = 31; i >= 0; --i) { const float t = v[i]; v[i] = tot; tot += t; }
        float suf = tot;
#pragma unroll
        for (int o = 1; o < 64; o <<= 1) { const float y = __shfl_down(suf, o); if (lane + o < 64) suf += y; }
        const float after = suf - tot;
        if ((lane >> 5) == half) {
#pragma unroll
            for (int i = 0; i < 32; i += 4) *(LAS f32x4*)(biasL + 32 * (lane & 31) + i) = (f32x4){(v[i] + after) * LOG2E, (v[i + 1] + after) * LOG2E, (v[i + 2] + after) * LOG2E, (v[i + 3] + after) * LOG2E};
        }
        if (half == 1) {
            const float* ln = F.out + O_LFS + (size_t)(b * TS) * FH + h; float acc = 0.f, mine = 0.f;
#pragma unroll
            for (int j = 0; j < TS; ++j) { acc += ln[(size_t)j * FH]; if (lane == j) mine = -acc * LOG2E; }
            if (lane < 16) biasL[1024 + lane] = mine;
        }
    }
    bf16x8 qf[2];
#pragma unroll
    for (int ks = 0; ks < 2; ++ks) { qf[ks] = (bf16x8){0, 0, 0, 0, 0, 0, 0, 0}; if (n16 < TS) qf[ks] = *(const bf16x8*)(F.QF + (size_t)(MP + b * TS + n16) * FW + h * FD + 32 * ks + 8 * g); }
    SaState S; S.m = -INFINITY; S.l = 0.f;
#pragma unroll
    for (int dt = 0; dt < 4; ++dt) S.o[dt] = (f32x4){0.f, 0.f, 0.f, 0.f};
    LDS_WAIT();
    SaBlk A, Bb;
    if (half == 1) {
        const float* kb = F.out + O_KS + (size_t)(b * TS) * FW + h * FD; const float* vb = F.out + O_VS + (size_t)(b * TS) * FW + h * FD;
#pragma unroll
        for (int ks = 0; ks < 2; ++ks) { const float* p = kb + (size_t)(n16 < TS ? n16 : TS - 1) * 512 + 32 * ks + 8 * g; A.k[0][ks][0] = *(const f32x4*)p; A.k[0][ks][1] = *(const f32x4*)(p + 4); A.k[1][ks][0] = A.k[0][ks][0]; A.k[1][ks][1] = A.k[0][ks][1]; }
#pragma unroll
        for (int e = 0; e < 4; ++e)
#pragma unroll
            for (int dt = 0; dt < 4; ++dt) { const int j = 4 * g + e; A.v[0][e][dt] = vb[(size_t)(j < TS ? j : TS - 1) * 512 + 16 * dt + n16]; A.v[1][e][dt] = 0.f; }
        sa_compute<true>(S, A, qf, biasL + 1024, n16, g);
    }
    const int sbase = 1024 * half;
#define SA_PTRS(blk, KB, VB) const float *KB, *VB; { const int s_ = sbase + 32 * (blk); const int pg_ = F.pt[b * NPG + (s_ >> 7)]; const size_t r_ = (((size_t)pg_ * PAGE + (s_ & 127)) * FH + h) * FD; KB = F.ck + r_; VB = F.cv + r_; }
    { SA_PTRS(31, k0, v0) sa_load(A, k0, v0, n16, g); }
    for (int blk = 31; blk >= 1; blk -= 2) {
        { SA_PTRS(blk - 1, k1, v1) sa_load(Bb, k1, v1, n16, g); }
        sa_compute<false>(S, A, qf, biasL + 32 * blk, n16, g);
        if (blk >= 2) { SA_PTRS(blk - 2, k2, v2) sa_load(A, k2, v2, n16, g); }
        sa_compute<false>(S, Bb, qf, biasL + 32 * (blk - 1), n16, g);
    }
#undef SA_PTRS
    float l = S.l; l += __shfl_xor(l, 16); l += __shfl_xor(l, 32);
    if (n16 < TS) {
        const size_t row = ((size_t)((b * 2 + half) * FH + h)) * TS + n16;
        float* pm = (float*)(F.ws + WS_SA_PM) + row * 2; float* po = (float*)(F.ws + WS_SA_PO) + row * 64;
        if (g == 0) { pm[0] = S.m; pm[1] = l; }
#pragma unroll
        for (int dt = 0; dt < 4; ++dt) *(f32x4*)(po + 16 * dt + 4 * g) = S.o[dt];
    }
}
__device__ __forceinline__ void p3_attn_sample(Frame& F) {
    for (int u = F.vcu; u < BS * 2; u += F.G) { sample_attn_unit(F, u >> 1, u & 1); __syncthreads(); }
}
__device__ __forceinline__ void p4_attn_sample_combine(Frame& F) {
    const int NT = F.G * NWAVES * 64;
    for (int i = blockIdx.x * (NWAVES * 64) + F.tid; i < BS * TS * FH * 16; i += NT) {
        const int dq = i & 15, h = (i >> 4) & 7, t = (i >> 7) & 7, b = i >> 10;
        const size_t r0 = ((size_t)((b * 2 + 0) * FH + h)) * TS + t, r1 = ((size_t)((b * 2 + 1) * FH + h)) * TS + t;
        const float* pm = (const float*)(F.ws + WS_SA_PM); const float* po = (const float*)(F.ws + WS_SA_PO);
        const float m0 = pm[r0 * 2], l0 = pm[r0 * 2 + 1], m1 = pm[r1 * 2], l1 = pm[r1 * 2 + 1];
        const float mm = fmaxf(m0, m1), w0 = exp2f(m0 - mm), w1 = exp2f(m1 - mm), inv = 1.0f / (w0 * l0 + w1 * l1);
        const f32x4 o0 = *(const f32x4*)(po + r0 * 64 + 4 * dq), o1 = *(const f32x4*)(po + r1 * 64 + 4 * dq);
        const f32x4 o = (o0 * w0 + o1 * w1) * inv;
        unsigned long long* dst = (unsigned long long*)(F.OF + (size_t)(MP + b * TS + t) * FW + h * FD + 4 * dq);
        *dst = (unsigned long long)pk2(o[0], o[1]) | ((unsigned long long)pk2(o[2], o[3]) << 32);
    }
}

constexpr size_t WS_OLOC = 688 * MiB, WS_QD = 722 * MiB, WS_UL = 739 * MiB, WS_DX = 787 * MiB;
constexpr int HG_QT = 0, HG_KT = 8704, HG_KD = 17408, HG_VT = 27648, HG_AB = 37888, HG_TOT = 40448, HG_DD = 42496, HG_PART = 43008, HG_END = 43008 + 8192;
constexpr int HG_NPU = BP * HH * 8, HG_NSU = BS * HH;
__device__ __forceinline__ int kpos(int k) { return (k & ~31) | (((k >> 2) & 3) << 3) | (((k >> 4) & 1) << 2) | (k & 3); }
typedef unsigned short us8 __attribute__((ext_vector_type(8)));

template <bool SMP> __device__ __forceinline__ void hgrn_local_unit(Frame& F, int u) {
    const int tid = F.tid, lane = F.lane, w = F.wave, g = lane >> 4, n16 = lane & 15, k = tid & 127, rg = tid >> 7;
    int b, h, m0;
    if (!SMP) { const int bh = u >> 3, j = u & 7; b = bh >> 2; h = bh & 3; m0 = b * TP + 256 * j; } else { const int sh = u - HG_NPU; b = sh >> 2; h = sh & 3; m0 = MP + TS * b; }
    constexpr int NCH = SMP ? 1 : 8;
    LAS unsigned char* L = F.lds + RING_OFF;
    LAS bf16* QT = (LAS bf16*)(L + HG_QT); LAS bf16* KT = (LAS bf16*)(L + HG_KT); LAS bf16* KD = (LAS bf16*)(L + HG_KD); LAS bf16* VT = (LAS bf16*)(L + HG_VT); LAS bf16* AB = (LAS bf16*)(L + HG_AB);
    LAS float* TOT = (LAS float*)(L + HG_TOT); LAS float* DD = (LAS float*)(L + HG_DD);
    const bool rowsok = !SMP || rg == 0;
    f32x4 Sacc[8];
#pragma unroll
    for (int i = 0; i < 8; ++i) Sacc[i] = (f32x4){0.f, 0.f, 0.f, 0.f};
    float Bprev = 0.f;
    float ng[8]; bf16 nq[8], nv[8];
    const size_t cb = (size_t)h * HK + k;
#pragma unroll
    for (int i = 0; i < 8; ++i) { ng[i] = 0.f; nq[i] = 0; nv[i] = 0; if (rowsok) { const size_t o = (size_t)(m0 + 8 * rg + i) * HW + cb; ng[i] = F.G2[o]; nq[i] = F.QH[o]; nv[i] = F.VH[o]; } }
    const int kp = kpos(k);
    for (int c = 0; c < NCH; ++c) {
        float gq[8]; bf16 qq[8], vv[8];
#pragma unroll
        for (int i = 0; i < 8; ++i) { gq[i] = ng[i]; qq[i] = nq[i]; vv[i] = nv[i]; }
        if (c + 1 < NCH) {
#pragma unroll
            for (int i = 0; i < 8; ++i) { const size_t o = (size_t)(m0 + 32 * (c + 1) + 8 * rg + i) * HW + cb; ng[i] = F.G2[o]; nq[i] = F.QH[o]; nv[i] = F.VH[o]; }
        }
        float cs[8]; float run = 0.f;
#pragma unroll
        for (int i = 0; i < 8; ++i) { run += gq[i]; cs[i] = run; }
        TOT[rg * 128 + k] = run;
        __syncthreads();
        const float t0 = TOT[k], t1 = TOT[128 + k], t2 = TOT[256 + k], t3 = TOT[384 + k];
        const float pre = (rg > 0 ? t0 : 0.f) + (rg > 1 ? t1 : 0.f) + (rg > 2 ? t2 : 0.f), bl = (t0 + t1) + (t2 + t3);
        const float eprev = __builtin_amdgcn_exp2f(Bprev);
        float kdv[8];
#pragma unroll
        for (int i = 0; i < 8; ++i) {
            const float bi = pre + cs[i], eb = __builtin_amdgcn_exp2f(bi), kk = 1.0f - __builtin_amdgcn_exp2f(gq[i]);
            const float qt = bf2f(qq[i]) * eb, kt = kk * __builtin_amdgcn_exp2f(-bi); kdv[i] = kk * __builtin_amdgcn_exp2f(bl - bi);
            const int r = 8 * rg + i;
            QT[r * 136 + kp] = (bf16)f2bf(qt); KT[r * 136 + kp] = (bf16)f2bf(kt);
            if (rowsok) F.ws_qd[(size_t)(m0 + 32 * c + r) * HW + h * HK + kp] = (bf16)f2bf(qt * eprev);
        }
        { u32x4_t wk; wk.x = pg8::cvt_pk_bf16(kdv[0], kdv[1]); wk.y = pg8::cvt_pk_bf16(kdv[2], kdv[3]); wk.z = pg8::cvt_pk_bf16(kdv[4], kdv[5]); wk.w = pg8::cvt_pk_bf16(kdv[6], kdv[7]);
          *(LAS u32x4_t*)(KD + k * 40 + 8 * rg) = wk;
          u32x4_t wv; wv.x = (unsigned)vv[0] | ((unsigned)vv[1] << 16); wv.y = (unsigned)vv[2] | ((unsigned)vv[3] << 16); wv.z = (unsigned)vv[4] | ((unsigned)vv[5] << 16); wv.w = (unsigned)vv[6] | ((unsigned)vv[7] << 16);
          *(LAS u32x4_t*)(VT + k * 40 + 8 * rg) = wv; }
        if (rg == 0) DD[k] = __builtin_amdgcn_exp2f(bl);
        Bprev += bl;
        __syncthreads();
        if (w < 4) {
            const int tt = w >> 1, ss = w & 1; f32x4 a = (f32x4){0.f, 0.f, 0.f, 0.f};
            if (!(tt == 0 && ss == 1)) {
#pragma unroll
                for (int ks = 0; ks < 4; ++ks) { const bf16x8 af = *(const LAS bf16x8*)(QT + (16 * tt + n16) * 136 + 32 * ks + 8 * g), bfr = *(const LAS bf16x8*)(KT + (16 * ss + n16) * 136 + 32 * ks + 8 * g);
                    a = __builtin_amdgcn_mfma_f32_16x16x32_bf16(af, bfr, a, 0, 0, 0); }
            }
#pragma unroll
            for (int i = 0; i < 4; ++i) { const int t = 16 * tt + 4 * g + i, s = 16 * ss + n16; AB[t * 40 + s] = (bf16)f2bf(s <= t ? a[i] : 0.f); }
        }
        __syncthreads();
        const bf16x8 vfr = *(const LAS bf16x8*)(VT + (16 * w + n16) * 40 + 8 * g);
        bf16x8 sfr[4];
#pragma unroll
        for (int j = 0; j < 4; ++j) sfr[j] = pk8(Sacc[2 * j][0], Sacc[2 * j][1], Sacc[2 * j][2], Sacc[2 * j][3], Sacc[2 * j + 1][0], Sacc[2 * j + 1][1], Sacc[2 * j + 1][2], Sacc[2 * j + 1][3]);
#pragma unroll
        for (int hh = 0; hh < (SMP ? 1 : 2); ++hh) {
            f32x4 acc = (f32x4){0.f, 0.f, 0.f, 0.f};
#pragma unroll
            for (int j = 0; j < 4; ++j) { const bf16x8 qfr = *(const LAS bf16x8*)(QT + (16 * hh + n16) * 136 + 32 * j + 8 * g); acc = __builtin_amdgcn_mfma_f32_16x16x32_bf16(sfr[j], qfr, acc, 0, 0, 0); }
            const bf16x8 abf = *(const LAS bf16x8*)(AB + (16 * hh + n16) * 40 + 8 * g);
            acc = __builtin_amdgcn_mfma_f32_16x16x32_bf16(vfr, abf, acc, 0, 0, 0);
            if (!SMP || n16 < TS) *(f32x4*)(F.ws_oloc + (size_t)(m0 + 32 * c + 16 * hh + n16) * HW + h * HK + 16 * w + 4 * g) = acc;
        }
#pragma unroll
        for (int kt = 0; kt < 8; ++kt) { const bf16x8 kdf = *(const LAS bf16x8*)(KD + (16 * kt + n16) * 40 + 8 * g); const f32x4 d4 = *(const LAS f32x4*)(DD + 16 * kt + 4 * g);
            Sacc[kt] = __builtin_amdgcn_mfma_f32_16x16x32_bf16(kdf, vfr, Sacc[kt] * d4, 0, 0, 0); }
    }
    f32x4* ul = (f32x4*)(F.ws + WS_UL) + ((size_t)(u * 8 + w) * 8) * 64 + lane;
#pragma unroll
    for (int kt = 0; kt < 8; ++kt) ul[kt * 64] = Sacc[kt];
    if (rg == 0) ((float*)(F.ws + WS_DX))[(size_t)u * HK + k] = __builtin_amdgcn_exp2f(Bprev);
    __syncthreads();
}
__device__ __forceinline__ void p3_hgrn_local(Frame& F) {
    for (int u = F.vcu; u < HG_NPU; u += F.G) hgrn_local_unit<false>(F, u);
    for (int u = HG_NPU + F.vcu; u < HG_NPU + HG_NSU; u += F.G) hgrn_local_unit<true>(F, u);
}

template <bool SMP> __device__ __forceinline__ void hgrn_fix_unit(Frame& F, int u) {
    const int lane = F.lane, w = F.wave, g = lane >> 4, n16 = lane & 15;
    int b, h, m0, j = 0;
    if (!SMP) { const int bh = u >> 3; j = u & 7; b = bh >> 2; h = bh & 3; m0 = b * TP + 256 * j; } else { const int sh = u - HG_NPU; b = sh >> 2; h = sh & 3; m0 = MP + TS * b; }
    constexpr int NCH = SMP ? 1 : 8, NHH = SMP ? 1 : 2;
    LAS float* PART = (LAS float*)(F.lds + RING_OFF + HG_PART);
    const float* DX = (const float*)(F.ws + WS_DX); const f32x4* UL = (const f32x4*)(F.ws + WS_UL);
    f32x4 S[8];
    if (!SMP) {
#pragma unroll
        for (int kt = 0; kt < 8; ++kt) S[kt] = (f32x4){0.f, 0.f, 0.f, 0.f};
        for (int jj = 0; jj < j; ++jj) { const int uu = u - j + jj;
#pragma unroll
            for (int kt = 0; kt < 8; ++kt) { const f32x4 dx = *(const f32x4*)(DX + (size_t)uu * HK + 16 * kt + 4 * g); S[kt] = S[kt] * dx + UL[((size_t)(uu * 8 + w) * 8 + kt) * 64 + lane]; } }
    } else {
        const float* sp = F.st0 + ((size_t)(b * HH + h) * HK) * HK + 16 * w + n16;
#pragma unroll
        for (int kt = 0; kt < 8; ++kt)
#pragma unroll
            for (int i = 0; i < 4; ++i) S[kt][i] = sp[(size_t)(16 * kt + 4 * g + i) * HK];
    }
    if (SMP || j == 7) {
        float* so = (SMP ? F.out + O_SS : F.out + O_SP) + ((size_t)(b * HH + h) * HK) * HK + 16 * w + n16;
#pragma unroll
        for (int kt = 0; kt < 8; ++kt) { const f32x4 dx = *(const f32x4*)(DX + (size_t)u * HK + 16 * kt + 4 * g); const f32x4 fin = S[kt] * dx + UL[((size_t)(u * 8 + w) * 8 + kt) * 64 + lane];
#pragma unroll
            for (int i = 0; i < 4; ++i) so[(size_t)(16 * kt + 4 * g + i) * HK] = fin[i]; }
    }
    bf16x8 sfr[4];
#pragma unroll
    for (int q = 0; q < 4; ++q) sfr[q] = pk8(S[2 * q][0], S[2 * q][1], S[2 * q][2], S[2 * q][3], S[2 * q + 1][0], S[2 * q + 1][1], S[2 * q + 1][2], S[2 * q + 1][3]);
    const bool rowok = !SMP || n16 < TS;
    f32x4 o[NCH][NHH];
#pragma unroll
    for (int c = 0; c < NCH; ++c)
#pragma unroll
        for (int hh = 0; hh < NHH; ++hh) {
            const int r = 32 * c + 16 * hh + n16; const size_t ro = (size_t)(m0 + r) * HW + h * HK;
            f32x4 acc = (f32x4){0.f, 0.f, 0.f, 0.f};
#pragma unroll
            for (int q = 0; q < 4; ++q) { bf16x8 qfr = (bf16x8){0, 0, 0, 0, 0, 0, 0, 0}; if (rowok) qfr = *(const bf16x8*)(F.ws_qd + ro + 32 * q + 8 * g); acc = __builtin_amdgcn_mfma_f32_16x16x32_bf16(sfr[q], qfr, acc, 0, 0, 0); }
            f32x4 ol = (f32x4){0.f, 0.f, 0.f, 0.f}; if (rowok) ol = *(const f32x4*)(F.ws_oloc + ro + 16 * w + 4 * g);
            o[c][hh] = ol + acc;
            float ss = (o[c][hh][0] * o[c][hh][0] + o[c][hh][1] * o[c][hh][1]) + (o[c][hh][2] * o[c][hh][2] + o[c][hh][3] * o[c][hh][3]);
            ss += __shfl_xor(ss, 16); ss += __shfl_xor(ss, 32);
            if (g == 0) PART[r * 8 + w] = ss;
        }
    __syncthreads();
    const f32x4 onw = *(const f32x4*)(F.onorm + 16 * w + 4 * g);
#pragma unroll
    for (int c = 0; c < NCH; ++c)
#pragma unroll
        for (int hh = 0; hh < NHH; ++hh) {
            const int r = 32 * c + 16 * hh + n16; const size_t ro = (size_t)(m0 + r) * HW + h * HK + 16 * w + 4 * g;
            const f32x4 p0 = *(const LAS f32x4*)(PART + r * 8), p1 = *(const LAS f32x4*)(PART + r * 8 + 4);
            const float rinv = 1.0f / sqrtf(((p0[0] + p0[1]) + (p0[2] + p0[3]) + (p1[0] + p1[1]) + (p1[2] + p1[3])) * (1.f / HK) + RMS_EPS);
            if (rowok) { const unsigned long long sgw = *(const unsigned long long*)(F.SG + ro);
                const float s0 = __uint_as_float((unsigned)(sgw << 16) ), s1 = __uint_as_float((unsigned)sgw & 0xffff0000u), s2 = __uint_as_float((unsigned)(sgw >> 32) << 16), s3 = __uint_as_float((unsigned)(sgw >> 32) & 0xffff0000u);
                const f32x4 y = o[c][hh] * rinv * onw;
                *(unsigned long long*)(F.OH + ro) = (unsigned long long)pk2(y[0] * s0, y[1] * s1) | ((unsigned long long)pk2(y[2] * s2, y[3] * s3) << 32); }
        }
    __syncthreads();
}
__device__ __forceinline__ void p4_hgrn_fix(Frame& F) {
    for (int u = F.vcu; u < HG_NPU; u += F.G) hgrn_fix_unit<false>(F, u);
    for (int u = HG_NPU + F.vcu; u < HG_NPU + HG_NSU; u += F.G) hgrn_fix_unit<true>(F, u);
}

__device__ __forceinline__ void fox_bias_prompt(Frame& F, int b, int h) {
    const float* lf = F.out + O_LFP + ((size_t)b * TP) * FH + h; const int s0 = 4 * F.tid, lane = F.lane;
    float a0 = lf[(size_t)s0 * FH], a1 = lf[(size_t)(s0 + 1) * FH], a2 = lf[(size_t)(s0 + 2) * FH], a3 = lf[(size_t)(s0 + 3) * FH];
    a1 += a0; a2 += a1; a3 += a2;
    float tot = a3;
#pragma unroll
    for (int o = 1; o < 64; o <<= 1) { const float y = __shfl_up(tot, o); if (lane >= o) tot += y; }
    LAS float* wt = (LAS float*)(F.lds + RING_OFF + attn_body::LDS_WS); LAS float* bias = (LAS float*)(F.lds + RING_OFF + attn_body::LDS_BIAS);
    if (lane == 63) wt[F.wave] = tot;
    __syncthreads();
    float pre = 0.f;
    for (int w = 0; w < F.wave; ++w) pre += wt[w];
    const float ex = pre + tot - a3;
    *(LAS f32x4*)(bias + s0) = (f32x4){-(ex + a0) * LOG2E, -(ex + a1) * LOG2E, -(ex + a2) * LOG2E, -(ex + a3) * LOG2E};
    __syncthreads();
}
__device__ __forceinline__ void p3_attn_prompt(Frame& F) {
    static_assert(attn_body::LDS_BYTES <= RING_BYTES && attn_body::DM == FW && attn_body::SEQ == TP && attn_body::BATCH == BP, "attention body geometry");
    char* shm = F.ldsg + RING_OFF;
    const attn_body::bf16 *Q = (const attn_body::bf16*)F.QF, *K = (const attn_body::bf16*)F.KF, *V = (const attn_body::bf16*)F.VF; attn_body::bf16* O = (attn_body::bf16*)F.OF;
    const int j = F.vcu;
    if (j < BP * FH * 4) {
        const int bh = j >> 2, s = j & 3, b = bh >> 3, h = bh & 7;
        fox_bias_prompt(F, b, h);
        for (int i = 0; i < 2; ++i) attn_body::attn_unit<8>(b, h, i ? s : 7 - s, Q, K, V, O, shm);
    }
}

#ifndef MK_N_LAUNCHES
#define MK_N_LAUNCHES 1
#endif
constexpr int NPHASE = 12;
constexpr int N_LAUNCHES = MK_N_LAUNCHES;
struct Args { const void* in[24]; float* out; unsigned char* ws; int ph_lo, ph_hi, li, pad; };
__global__ void __launch_bounds__(NWAVES * 64, 2) fwd_kernel(Args args) {
    extern __shared__ __attribute__((aligned(16))) unsigned char lds[];
    Frame F;
    F.lds = (LAS unsigned char*)lds; F.ldsg = (char*)lds; F.MISC = (volatile LAS unsigned*)(F.lds + MISC_OFF);
    F.tid = threadIdx.x; F.lane = F.tid & 63; F.wave = __builtin_amdgcn_readfirstlane(F.tid >> 6);
    F.G = gridDim.x; { const int bx = blockIdx.x; F.vcu = (F.G % 8 == 0) ? (bx % 8) * (F.G / 8) + bx / 8 : bx; }
    unsigned char* ws = args.ws; F.ws = ws; F.out = args.out;
    F.ctl = (gu32*)(ws + WS_CTL);
    F.xp = (const float*)args.in[0]; F.xs = (const float*)args.in[1]; F.cp = (const float*)args.in[2]; F.cs = (const float*)args.in[3];
    F.ck = (const float*)args.in[4]; F.cv = (const float*)args.in[5]; F.clf = (const float*)args.in[6]; F.st0 = (const float*)args.in[7]; F.pt = (const int*)args.in[8];
    F.ada_w = (const float*)args.in[9]; F.ada_b = (const float*)args.in[10]; F.n1pre = (const float*)args.in[11]; F.n1post = (const float*)args.in[12];
    F.n2pre = (const float*)args.in[13]; F.n2post = (const float*)args.in[14]; F.w_in = (const float*)args.in[15]; F.lbw = (const float*)args.in[16];
    F.onorm = (const float*)args.in[17]; F.fxb = (const float*)args.in[18]; F.w_brh = (const float*)args.in[19]; F.w_brf = (const float*)args.in[20];
    F.w_out = (const float*)args.in[21]; F.w_up = (const float*)args.in[22]; F.w_dn = (const float*)args.in[23];
    F.MOD = (float*)(ws + WS_MOD); F.Win_t = (bf16*)(ws + WS_WIN); F.Wbh_t = (bf16*)(ws + WS_WBH); F.Wbf_t = (bf16*)(ws + WS_WBF); F.Wout_t = (bf16*)(ws + WS_WOUT);
    F.Wup_t = (bf16*)(ws + WS_WUP); F.Wdn_t = (bf16*)(ws + WS_WDN); F.H = (bf16*)(ws + WS_H); F.QH = (bf16*)(ws + WS_QH); F.VH = (bf16*)(ws + WS_VH); F.SG = (bf16*)(ws + WS_SG);
    F.QF = (bf16*)(ws + WS_QF); F.KF = (bf16*)(ws + WS_KF); F.VF = (bf16*)(ws + WS_VF); F.G2 = (float*)(ws + WS_G2); F.MG = (bf16*)(ws + WS_MG); F.OF = (bf16*)(ws + WS_OF);
    F.OH = (bf16*)(ws + WS_OH); F.T1 = (float*)(ws + WS_T1); F.MRG = (bf16*)(ws + WS_MRG); F.Y = (float*)(ws + WS_Y); F.ACT = (bf16*)(ws + WS_ACT); F.U2 = (float*)(ws + WS_U2); F.ws_qd = (bf16*)(ws + WS_QD); F.ws_oloc = (float*)(ws + WS_OLOC);
    for (int u = F.tid; u < (LDS_BYTES - LDSCTL_OFF) / 4; u += NWAVES * 64) ((LAS unsigned*)(F.lds + LDSCTL_OFF))[u] = 0u;
    __syncthreads();
    XcdBarrier bar; bar.bar = (unsigned*)(F.ctl + CW_BAR); bar.x = 0; bar.st = nullptr;
    if (N_LAUNCHES == 1) bar = xcd_barrier_post((unsigned*)(F.ctl + CW_BAR), F.MISC + 8);
#define GRID_BAR(seam) do { if (N_LAUNCHES != 1) { if (F.tid == 0) __hip_atomic_store(F.ctl + CW_TMO, 0xBADBA0u | (unsigned)(seam), RLX_AGENT); } else { xcd_barrier(bar); } } while (0)
    const int lo = args.ph_lo, hi = args.ph_hi;
#define IN(k) (lo <= (k) && (k) < hi)
#define BOTH(k) (IN(k) && IN((k) + 1))
    if (IN(0)) { p0_prologue(F); if (BOTH(0)) GRID_BAR(0); }
    if (IN(1)) { p1_norm1(F); if (BOTH(1)) GRID_BAR(1); }
    if (IN(2)) {
        pg8::Gemm g{F.H, F.Win_t, M, NPROJ, DM}; pg8::StaticOrder S; S.init(M, NPROJ, F.G, (int)blockIdx.x);
        EpiProj E{F.QH, F.VH, F.SG, F.QF, F.KF, F.VF, F.MG, F.G2, F.out, F.lbw};
        pg8::gemm_phase<EpiProj, pg8::StaticOrder, PG8_ALIGN, PG8_SP2>(F.lds + RING_OFF, g, S, E);
        if (BOTH(2)) GRID_BAR(2);
    }
    if (IN(3)) { p3_attn_prompt(F); __syncthreads(); p3_attn_sample(F); __syncthreads(); p3_hgrn_local(F); if (BOTH(3)) GRID_BAR(3); }
    if (IN(4)) { p4_attn_sample_combine(F); p4_hgrn_fix(F); if (BOTH(4)) GRID_BAR(4); }
    if (IN(5)) {
        pg8::Gemm g{F.OH, F.Wbh_t, M, DM, HW}; pg8::StaticOrder S; S.init(M, DM, F.G, (int)blockIdx.x);
        EpiBrH E{F.MG, F.T1};
        pg8::gemm_phase<EpiBrH, pg8::StaticOrder, PG8_ALIGN, PG8_SP2>(F.lds + RING_OFF, g, S, E);
        if (BOTH(5)) GRID_BAR(5);
    }
    if (IN(6)) {
        pg8::Gemm g{F.OF, F.Wbf_t, M, DM, FW}; pg8::StaticOrder S; S.init(M, DM, F.G, (int)blockIdx.x);
        EpiBrF E{F.MG, F.T1, F.MRG};
        pg8::gemm_phase<EpiBrF, pg8::StaticOrder, PG8_ALIGN, PG8_SP2>(F.lds + RING_OFF, g, S, E);
        if (BOTH(6)) GRID_BAR(6);
    }
    if (IN(7)) {
        pg8::Gemm g{F.MRG, F.Wout_t, M, DM, DM}; pg8::StaticOrder S; S.init(M, DM, F.G, (int)blockIdx.x);
        EpiF32 E{F.Y, DM};
        pg8::gemm_phase<EpiF32, pg8::StaticOrder, PG8_ALIGN, PG8_SP2>(F.lds + RING_OFF, g, S, E);
        if (BOTH(7)) GRID_BAR(7);
    }
    if (IN(8)) { p8_midnorm(F); if (BOTH(8)) GRID_BAR(8); }
    if (IN(9)) {
        pg8::Gemm g{F.H, F.Wup_t, M, DFF, DM}; pg8::StaticOrder S; S.init(M, DFF, F.G, (int)blockIdx.x);
        EpiRelu2 E{F.ACT, DFF};
        pg8::gemm_phase<EpiRelu2, pg8::StaticOrder, PG8_ALIGN, PG8_SP2>(F.lds + RING_OFF, g, S, E);
        if (BOTH(9)) GRID_BAR(9);
    }
    if (IN(10)) {
        pg8::Gemm g{F.ACT, F.Wdn_t, M, DM, DFF}; pg8::StaticOrder S; S.init(M, DM, F.G, (int)blockIdx.x);
        EpiF32 E{F.U2, DM};
        pg8::gemm_phase<EpiF32, pg8::StaticOrder, PG8_ALIGN, PG8_SP2>(F.lds + RING_OFF, g, S, E);
        if (BOTH(10)) GRID_BAR(10);
    }
    if (IN(11)) { p11_final(F); }
#undef IN
#undef BOTH
}

extern "C" void kernel_launch(void* const* d_in, const int* in_sizes, int n_in, void* d_out, int out_size, void* d_ws, size_t ws_size, hipStream_t stream) {
    static int grid = 0;
    if (grid == 0) {
        if (n_in != 24 || (size_t)out_size != O_END || ws_size < WS_END) { fprintf(stderr, "kernel_launch: unexpected shapes: n_in %d out %d ws %zu (need %zu)\n", n_in, out_size, ws_size, (size_t)WS_END); grid = -1; return; }
        int dev = 0, cus = 0, per_cu = 0;
        if (hipGetDevice(&dev) != hipSuccess || hipDeviceGetAttribute(&cus, hipDeviceAttributeMultiprocessorCount, dev) != hipSuccess) { grid = -1; return; }
        if (hipFuncSetAttribute((const void*)fwd_kernel, hipFuncAttributeMaxDynamicSharedMemorySize, LDS_BYTES) != hipSuccess) { fprintf(stderr, "kernel_launch: hipFuncSetAttribute failed\n"); grid = -1; return; }
        if (hipOccupancyMaxActiveBlocksPerMultiprocessor(&per_cu, (const void*)fwd_kernel, NWAVES * 64, LDS_BYTES) != hipSuccess || per_cu < 1) fprintf(stderr, "kernel_launch: occupancy query reports %d\n", per_cu);
        (void)hipGetLastError();
        grid = cus;
    }
    if (grid < 0) return;
    if (hipMemsetAsync((char*)d_ws + WS_CTL, 0, CTL_ZERO_BYTES, stream) != hipSuccess) return;
    Args a{};
    for (int i = 0; i < 24; ++i) a.in[i] = d_in[i];
    a.out = (float*)d_out; a.ws = (unsigned char*)d_ws;
    if (N_LAUNCHES == 1) { a.ph_lo = 0; a.ph_hi = NPHASE; a.li = 0; hipLaunchKernelGGL(fwd_kernel, dim3(grid), dim3(NWAVES * 64), LDS_BYTES, stream, a); }
    else for (int li = 0; li < NPHASE; ++li) { a.ph_lo = li; a.ph_hi = li + 1; a.li = li; hipLaunchKernelGGL(fwd_kernel, dim3(grid), dim3(NWAVES * 64), LDS_BYTES, stream, a); }
    const hipError_t le = hipPeekAtLastError();
    if (le != hipSuccess) fprintf(stderr, "kernel_launch: launch failed: %s\n", hipGetErrorName(le));
}
```

```cpp
#include <hip/hip_runtime.h>
#include <cstdio>
#include <cstdint>
namespace pg8 {
#define PG8_LAS __attribute__((address_space(3)))
typedef unsigned short bf16_t;
typedef short bf16x8 __attribute__((ext_vector_type(8)));
typedef float f32x4 __attribute__((ext_vector_type(4)));
typedef unsigned u32x4 __attribute__((ext_vector_type(4)));
constexpr int BM = 256, BK = 64, HALF = 128, HTB = HALF * BK * 2  , STAGE_BYTES = 8 * HTB, NXCD = 8, WGM = 8;

__host__ __device__ __forceinline__ int lds_byte(int r, int c) { const int st = (r >> 4) * 2 + (c >> 5), rr = r & 15, cc = c & 31, ob = rr * 64 + cc * 2; return st * 1024 + (ob ^ (((ob >> 9) & 1) << 5)); }
__host__ __device__ __forceinline__ void stage_rc(int b, int& R, int& C) { const int st = b / 1024, sb = b % 1024, swz = sb ^ (((sb >> 9) & 1) << 5); R = (st >> 1) * 16 + swz / 64; C = (st & 1) * 32 + (swz % 64) / 2; }
__host__ __device__ __forceinline__ int perm32(int rho) { const int n = rho >> 4, i = rho & 15; return 8 * (i >> 2) + 4 * n + (i & 3); }

struct Unit { int pm, pn, sel, koff, aux; };
struct Gemm { const bf16_t* A; const bf16_t* Bt; int M, N, K, ld; const bf16_t* A2; const bf16_t* Bt2; };

struct StaticOrder {
    int nM, nN, nwg, G, c;
    __host__ __device__ void init(int M, int N, int G_, int c_) { nM = M / BM; nN = N / BM; nwg = nM * nN; G = G_; c = c_; }
    __host__ __device__ bool next(int i, Unit& u) const {
        const long L = (long)i * G + c; if (L >= nwg) return false;
        int wgid = (int)L; { const int q = nwg / NXCD, r = nwg % NXCD, xcd = wgid % NXCD, off = wgid / NXCD; wgid = (xcd < r ? xcd * (q + 1) : r * (q + 1) + (xcd - r) * q) + off; }
        const int nig = WGM * nN, gid = wgid / nig, fm = gid * WGM, gsz = (nM - fm) < WGM ? (nM - fm) : WGM;
        u.pm = fm + ((wgid % nig) % gsz); u.pn = (wgid % nig) / gsz; u.sel = 0; u.koff = 0; u.aux = 0; return true;
    }
    __device__ __forceinline__ void a_ready(const Unit&) const {}
    __device__ __forceinline__ void done(const Unit&) const {}
};

__device__ __forceinline__ unsigned cvt_pk_bf16(float lo, float hi) { unsigned r; asm volatile("v_cvt_pk_bf16_f32 %0, %1, %2" : "=v"(r) : "v"(lo), "v"(hi)); return r; }
typedef float f32x2 __attribute__((ext_vector_type(2)));
template <class Epi, class Sched, bool ALIGN_EPI = false, bool SP2 = false>
__device__ __forceinline__ void gemm_phase(PG8_LAS unsigned char* lds, const Gemm g, const Sched& S, const Epi& E) {
    const int tid = threadIdx.x, wid = __builtin_amdgcn_readfirstlane(tid >> 6), lane = tid & 63, wr = wid >> 2, wc = wid & 3, fr = lane & 15, fq = lane >> 4;
    const int K = g.ld, nt = g.K / BK;
    unsigned voffA[2], voffB[2];
#pragma unroll
    for (int i = 0; i < 2; ++i) { int R, C; stage_rc(tid * 16 + i * 8192, R, C); const int Rb = Epi::PERM ? ((R & ~31) + perm32(R & 31)) : R;
        voffA[i] = (unsigned)(R * K + C) * 2u; voffB[i] = (unsigned)(Rb * K + C) * 2u; }
    const size_t kstep = (size_t)(BK * 2);
    const size_t hstep = (size_t)HALF * K * 2;
    const size_t tstep = 2 * hstep;
    const unsigned ldsw = (unsigned)wid * 1024u;
    const int aoff = lds_byte(wr * 64 + fr, fq * 8), boff = lds_byte(wc * 32 + fr, fq * 8);
#define PG8_SA(b, h) (((b) * 2 + (h)) * HTB)
#define PG8_SB(b, h) ((4 + (b) * 2 + (h)) * HTB)
#define PG8_STAGE(bufoff, gbase, voff) do { _Pragma("unroll") for (int _i = 0; _i < 2; ++_i) \
        __builtin_amdgcn_global_load_lds((const unsigned*)((const char*)(gbase) + (voff)[_i]), (PG8_LAS unsigned*)(lds + (bufoff) + ldsw + _i * 8192), 16, 0, 0); } while (0)
#define PG8_LDA(dst, b, h) do { _Pragma("unroll") for (int m = 0; m < 4; ++m) _Pragma("unroll") for (int k = 0; k < 2; ++k) dst[m][k] = *(const PG8_LAS bf16x8*)(lds + PG8_SA(b, h) + aoff + m * 2048 + k * 1024); } while (0)
#define PG8_LDB(dst, b, h) do { _Pragma("unroll") for (int n = 0; n < 2; ++n) _Pragma("unroll") for (int k = 0; k < 2; ++k) dst[n][k] = *(const PG8_LAS bf16x8*)(lds + PG8_SB(b, h) + boff + n * 2048 + k * 1024); } while (0)
#define PG8_MMA(ai, bj, At, Bt) do { __builtin_amdgcn_s_setprio(1); _Pragma("unroll") for (int m = 0; m < 4; ++m) _Pragma("unroll") for (int n = 0; n < 2; ++n) _Pragma("unroll") for (int k = 0; k < 2; ++k) \
        acc[ai][bj][m][n] = __builtin_amdgcn_mfma_f32_16x16x32_bf16(Bt[n][k], At[m][k], acc[ai][bj][m][n], 0, 0, 0); __builtin_amdgcn_s_setprio(0); } while (0)
#define PG8_WAIT_V(n) asm volatile("s_waitcnt vmcnt(" #n ")" ::: "memory")
#define PG8_WAIT_L(n) asm volatile("s_waitcnt lgkmcnt(" #n ")" ::: "memory")
#define PG8_BAR __builtin_amdgcn_s_barrier()
#define PG8_SCHED __builtin_amdgcn_sched_barrier(0)
    Unit cur, nxt; int ui = 0;
    if (!S.next(0, cur)) return;
    f32x4 acc[2][2][4][2];
#pragma unroll
    for (int a = 0; a < 2; ++a)
#pragma unroll
        for (int b = 0; b < 2; ++b)
#pragma unroll
            for (int m = 0; m < 4; ++m)
#pragma unroll
                for (int n = 0; n < 2; ++n) acc[a][b][m][n] = (f32x4){0.f, 0.f, 0.f, 0.f};
    bf16x8 At[4][2], B0[2][2], B1[2][2];
    const char* cA = (const char*)(cur.sel ? g.A2 : g.A) + (size_t)cur.pm * tstep + (size_t)cur.koff * 2; const char* cB = (const char*)(cur.sel ? g.Bt2 : g.Bt) + (size_t)cur.pn * tstep + (size_t)cur.koff * 2;
    S.a_ready(cur);
    if constexpr (SP2) {
        PG8_STAGE(PG8_SB(0, 0), cB, voffB); PG8_STAGE(PG8_SB(0, 1), cB + hstep, voffB); PG8_STAGE(PG8_SA(0, 0), cA, voffA); PG8_STAGE(PG8_SA(0, 1), cA + hstep, voffA);
        if (wr == 1) PG8_BAR;
        PG8_WAIT_V(2); PG8_BAR;
        PG8_STAGE(PG8_SB(1, 0), cB + kstep, voffB); PG8_STAGE(PG8_SA(1, 0), cA + kstep, voffA); PG8_STAGE(PG8_SB(1, 1), cB + hstep + kstep, voffB);
        PG8_WAIT_V(6); PG8_BAR;
    } else {
        PG8_STAGE(PG8_SB(0, 0), cB, voffB); PG8_STAGE(PG8_SA(0, 0), cA, voffA); PG8_STAGE(PG8_SB(0, 1), cB + hstep, voffB); PG8_STAGE(PG8_SA(0, 1), cA + hstep, voffA);
        if (wr == 1) PG8_BAR;
        PG8_WAIT_V(4); PG8_BAR;
        PG8_STAGE(PG8_SB(1, 0), cB + kstep, voffB); PG8_STAGE(PG8_SA(1, 0), cA + kstep, voffA); PG8_STAGE(PG8_SB(1, 1), cB + hstep + kstep, voffB);
        PG8_WAIT_V(6); PG8_BAR;
    }
    for (;;) {
        const bool has_next = S.next(ui + 1, nxt);
        const char* nA = has_next ? (const char*)(nxt.sel ? g.A2 : g.A) + (size_t)nxt.pm * tstep + (size_t)nxt.koff * 2 : cA; const char* nB = has_next ? (const char*)(nxt.sel ? g.Bt2 : g.Bt) + (size_t)nxt.pn * tstep + (size_t)nxt.koff * 2 : cB;
        for (int t = 0; t < nt; t += 2) {
            const bool last = (t == nt - 2);
            const char* a1 = cA + (size_t)(t + 1) * kstep;
            const char* a2 = last ? nA : cA + (size_t)(t + 2) * kstep; const char* b2 = last ? nB : cB + (size_t)(t + 2) * kstep;
            const char* a3 = a2 + kstep; const char* b3 = b2 + kstep;
            if (last && has_next) S.a_ready(nxt);
            if constexpr (SP2) {
            PG8_LDB(B0, 0, 0); PG8_LDB(B1, 0, 1); PG8_SCHED; PG8_LDA(At, 0, 0); PG8_STAGE(PG8_SA(1, 1), a1 + hstep, voffA);
            PG8_WAIT_V(8); PG8_WAIT_L(0); PG8_BAR; PG8_MMA(0, 0, At, B0); PG8_MMA(0, 1, At, B1); PG8_BAR; PG8_SCHED;
            PG8_LDA(At, 0, 1); PG8_STAGE(PG8_SB(0, 0), b2, voffB); PG8_STAGE(PG8_SB(0, 1), b2 + hstep, voffB); PG8_STAGE(PG8_SA(0, 0), a2, voffA);
            PG8_WAIT_V(8); PG8_WAIT_L(0); PG8_BAR; PG8_MMA(1, 0, At, B0); PG8_MMA(1, 1, At, B1); PG8_BAR; PG8_SCHED;
            PG8_LDB(B0, 1, 0); PG8_LDB(B1, 1, 1); PG8_SCHED; PG8_LDA(At, 1, 0); PG8_STAGE(PG8_SA(0, 1), a2 + hstep, voffA);
            PG8_WAIT_V(8); PG8_WAIT_L(0); PG8_BAR; PG8_MMA(0, 0, At, B0); PG8_MMA(0, 1, At, B1); PG8_BAR; PG8_SCHED;
            PG8_LDA(At, 1, 1); PG8_STAGE(PG8_SB(1, 0), b3, voffB); PG8_STAGE(PG8_SB(1, 1), b3 + hstep, voffB); PG8_STAGE(PG8_SA(1, 0), a3, voffA);
            PG8_WAIT_V(8); PG8_WAIT_L(0); PG8_BAR; PG8_MMA(1, 0, At, B0); PG8_MMA(1, 1, At, B1); PG8_BAR; PG8_SCHED;
            } else {
            PG8_LDB(B0, 0, 0); PG8_SCHED; PG8_LDA(At, 0, 0); PG8_STAGE(PG8_SA(1, 1), a1 + hstep, voffA);
            PG8_WAIT_L(8); PG8_BAR; PG8_WAIT_L(0); PG8_MMA(0, 0, At, B0); PG8_BAR; PG8_SCHED;
            PG8_LDB(B1, 0, 1); PG8_STAGE(PG8_SB(0, 0), b2, voffB);
            PG8_BAR; PG8_WAIT_L(0); PG8_MMA(0, 1, At, B1); PG8_BAR;
            PG8_LDA(At, 0, 1); PG8_STAGE(PG8_SA(0, 0), a2, voffA);
            PG8_BAR; PG8_WAIT_L(0); PG8_MMA(1, 0, At, B0); PG8_BAR; PG8_SCHED;
            PG8_STAGE(PG8_SB(0, 1), b2 + hstep, voffB);
            PG8_WAIT_V(6); PG8_BAR; PG8_MMA(1, 1, At, B1); PG8_BAR;
            PG8_LDB(B0, 1, 0); PG8_SCHED; PG8_LDA(At, 1, 0); PG8_STAGE(PG8_SA(0, 1), a2 + hstep, voffA);
            PG8_WAIT_L(8); PG8_BAR; PG8_WAIT_L(0); PG8_MMA(0, 0, At, B0); PG8_BAR; PG8_SCHED;
            PG8_LDB(B1, 1, 1); PG8_STAGE(PG8_SB(1, 0), b3, voffB);
            PG8_BAR; PG8_WAIT_L(0); PG8_MMA(0, 1, At, B1); PG8_BAR;
            PG8_LDA(At, 1, 1); PG8_STAGE(PG8_SA(1, 0), a3, voffA);
            PG8_BAR; PG8_WAIT_L(0); PG8_MMA(1, 0, At, B0); PG8_BAR; PG8_SCHED;
            PG8_STAGE(PG8_SB(1, 1), b3 + hstep, voffB);
            PG8_WAIT_V(6); PG8_BAR; PG8_MMA(1, 1, At, B1); PG8_BAR;
            }
        }
        if constexpr (ALIGN_EPI) { if (wr == 0) PG8_BAR; }
        if constexpr (Epi::KEEPS) { E.mid(acc, cur, wr, wc, fr, fq); S.done(cur); } else if constexpr (!Epi::AFTER_DRAIN) { E(acc, cur, wr, wc, fr, fq); S.done(cur); }
        if (!has_next) break;
        if (!(Epi::KEEPS && cur.sel == 0)) {
#pragma unroll
        for (int a = 0; a < 2; ++a)
#pragma unroll
            for (int b = 0; b < 2; ++b)
#pragma unroll
                for (int m = 0; m < 4; ++m)
#pragma unroll
                    for (int n = 0; n < 2; ++n) acc[a][b][m][n] = (f32x4){0.f, 0.f, 0.f, 0.f};
        }
        cur = nxt; cA = nA; cB = nB; ++ui;
        if constexpr (ALIGN_EPI) { if (wr == 1) PG8_BAR; }
    }
    PG8_WAIT_V(0);
    if constexpr (!ALIGN_EPI) { if (wr == 0) PG8_BAR; }
    PG8_BAR;
    if constexpr (Epi::AFTER_DRAIN) { E.fused(acc, cur, wr, wc, fr, fq, lds, wid, lane); S.done(cur); }
#undef PG8_SA
#undef PG8_SB
#undef PG8_STAGE
#undef PG8_LDA
#undef PG8_LDB
#undef PG8_MMA
#undef PG8_WAIT_V
#undef PG8_WAIT_L
#undef PG8_BAR
#undef PG8_SCHED
}
}

#ifndef PG8_SP2
#define PG8_SP2 true
#endif
#ifndef PG8_ALIGN
#define PG8_ALIGN true
#endif
#define GAS __attribute__((address_space(1)))
#define LAS __attribute__((address_space(3)))
typedef unsigned short bf16;
typedef unsigned v4u __attribute__((ext_vector_type(4)));
typedef float f32x4 __attribute__((ext_vector_type(4)));
typedef short bf16x8 __attribute__((ext_vector_type(8)));
typedef GAS unsigned gu32;
typedef GAS unsigned long long gu64;
#define RLX_AGENT __ATOMIC_RELAXED, __HIP_MEMORY_SCOPE_AGENT
#define LDS_WAIT() asm volatile("s_waitcnt lgkmcnt(0)" ::: "memory")
#define VM_WAIT() asm volatile("s_waitcnt vmcnt(0)" ::: "memory")
__device__ __forceinline__ unsigned long long rt() { return __builtin_amdgcn_s_memrealtime(); }
__device__ __forceinline__ unsigned f2bf(float f) { unsigned u = __builtin_bit_cast(unsigned, f); return (u + 0x7fffu + ((u >> 16) & 1u)) >> 16; }
__device__ __forceinline__ unsigned pk2(float lo, float hi) { return f2bf(lo) | (f2bf(hi) << 16); }

#define XB_TMO      128
#define XB_XCNT(j)  (256  + 64 * (j))
#define XB_XSUB(j)  (1280 + 64 * (j))
#define XB_XGEN(j)  (2304 + 64 * (j))
#define XB_TOP      3328
#define XB_TOPGEN   3392
#define XCD_BAR_WORDS 3456
#define XB_SPIN_CAP (1u << 18)

__device__ __forceinline__ unsigned xb_ld(unsigned* p)              { return __hip_atomic_load(p, __ATOMIC_RELAXED, __HIP_MEMORY_SCOPE_AGENT); }
__device__ __forceinline__ unsigned xb_add(unsigned* p, unsigned v) { return __hip_atomic_fetch_add(p, v, __ATOMIC_RELAXED, __HIP_MEMORY_SCOPE_AGENT); }
__device__ __forceinline__ unsigned xb_xcc_id() { return (unsigned)__builtin_amdgcn_s_getreg((3 << 11) | 20) & 0xFu; }
#define XB_SPIN(cond, bar) do { unsigned _sp = 0; while (cond) { __builtin_amdgcn_s_sleep(1); \
    if ((++_sp & 255u) == 0u) { if (xb_ld(&(bar)[XB_TMO])) break; if (_sp > XB_SPIN_CAP) { atomicAdd(&(bar)[XB_TMO], 1u); break; } } } } while (0)

struct XcdBarrier {
    unsigned* bar; unsigned x;
    volatile LAS unsigned* st;
};

__device__ __forceinline__ XcdBarrier xcd_barrier_post(unsigned* bar, volatile LAS unsigned* st) {
    XcdBarrier b; b.bar = bar; b.x = xb_xcc_id(); b.st = st;
    if (threadIdx.x == 0) (void)xb_add(&bar[XB_XCNT(b.x)], 1u);
    return b;
}
__device__ __forceinline__ void xcd_barrier_complete(unsigned* bar, unsigned x, unsigned& nloc, unsigned& nx) {
    const unsigned G = gridDim.x * gridDim.y * gridDim.z;
    unsigned sum, cnt, mine, sp = 0u;
    for (;;) {
        sum = 0u; cnt = 0u; mine = 0u;
#pragma unroll
        for (unsigned j = 0; j < 16; ++j) { const unsigned c = xb_ld(&bar[XB_XCNT(j)]); sum += c; cnt += (c > 0u) ? 1u : 0u; mine = (j == x) ? c : mine; }
        if (sum == G) break;
        __builtin_amdgcn_s_sleep(1);
        if ((++sp & 255u) == 0u) { if (xb_ld(&bar[XB_TMO])) break; if (sp > XB_SPIN_CAP) { atomicAdd(&bar[XB_TMO], 1u); break; } }
    }
    nloc = mine > 0u ? mine : 1u; nx = cnt > 0u ? cnt : 1u;
}

__device__ __forceinline__ void xcd_barrier(const XcdBarrier& b) {
    asm volatile("s_waitcnt vmcnt(0)" ::: "memory");
    __syncthreads();
    if (threadIdx.x == 0) {
        unsigned* bar = b.bar;
        __builtin_amdgcn_s_waitcnt(0);
        unsigned nloc = b.st[0], nx = b.st[1];
        if (nloc == 0u) { xcd_barrier_complete(bar, b.x, nloc, nx); b.st[0] = nloc; b.st[1] = nx; }
        const unsigned old = xb_add(&bar[XB_XSUB(b.x)], 1u);
        const unsigned gen = old / nloc;
        if (old + 1u == (gen + 1u) * nloc) {
            __builtin_amdgcn_fence(__ATOMIC_RELEASE, "agent");
            asm volatile("s_waitcnt vmcnt(0)" ::: "memory");
            const unsigned og = xb_add(&bar[XB_TOP], 1u);
            const unsigned tg = og / nx;
            if (og + 1u == (tg + 1u) * nx) xb_add(&bar[XB_TOPGEN], 1u);
            else XB_SPIN(xb_ld(&bar[XB_TOPGEN]) == tg, bar);
            __builtin_amdgcn_fence(__ATOMIC_ACQUIRE, "agent");
            xb_add(&bar[XB_XGEN(b.x)], 1u);
            asm volatile("s_waitcnt vmcnt(0)" ::: "memory");
        } else {
            XB_SPIN(xb_ld(&bar[XB_XGEN(b.x)]) == gen, bar);
            __builtin_amdgcn_fence(__ATOMIC_ACQUIRE, "agent");
            asm volatile("s_waitcnt vmcnt(0)" ::: "memory");
        }
    }
    __syncthreads();
}


constexpr int NWAVES = 8;
constexpr int DM = 1024, BP = 8, TP = 2048, MP = BP * TP, BS = 128, TS = 8, MS = BS * TS, M = MP + MS;
constexpr int PAST = 2048, PAGE = 128, NPG = PAST / PAGE;
constexpr int HH = 4, HK = 128, HW = 512, FH = 8, FD = 64, FW = 512, DFF = 4096, INC = 5640, NPROJ = 5632, NMOD = 6144, NMODR = BP + BS;
constexpr float RMS_EPS = 1e-6f, LOG2E = 1.4426950408889634f;
constexpr float C2 = 0.125f * LOG2E;
constexpr float HQ_SCALE = 0.08838834764831845f;
constexpr size_t O_Y = 0, O_KP = (size_t)M * DM, O_VP = O_KP + (size_t)MP * FW, O_LFP = O_VP + (size_t)MP * FW, O_SP = O_LFP + (size_t)MP * FH,
                 O_KS = O_SP + (size_t)BP * HH * HK * HK, O_VS = O_KS + (size_t)MS * FW, O_LFS = O_VS + (size_t)MS * FW, O_SS = O_LFS + (size_t)MS * FH,
                 O_END = O_SS + (size_t)BS * HH * HK * HK;
constexpr size_t MiB = 1u << 20;
constexpr size_t WS_CTL = 0, CTL_ZERO_BYTES = 1 * MiB;
constexpr size_t WS_MOD = 1 * MiB, WS_WIN = 5 * MiB, WS_WBH = 16 * MiB, WS_WBF = 17 * MiB, WS_WOUT = 18 * MiB, WS_WUP = 20 * MiB, WS_WDN = 28 * MiB;
constexpr size_t WS_H = 36 * MiB, WS_QH = 70 * MiB, WS_VH = 87 * MiB, WS_SG = 104 * MiB, WS_QF = 121 * MiB, WS_KF = 138 * MiB, WS_VF = 155 * MiB;
constexpr size_t WS_G2 = 172 * MiB, WS_MG = 206 * MiB, WS_OF = 274 * MiB, WS_OH = 291 * MiB, WS_T1 = 308 * MiB, WS_MRG = 376 * MiB, WS_Y = 410 * MiB;
constexpr size_t WS_ACT = 478 * MiB, WS_U2 = 614 * MiB, WS_HG = 682 * MiB, WS_SLABD = 788 * MiB, WS_SLABO = 820 * MiB, WS_END = 840 * MiB;
static_assert((size_t)M * DM * 2 <= 34 * MiB && (size_t)M * HW * 2 <= 17 * MiB && (size_t)M * DFF * 2 <= 136 * MiB && (size_t)NPROJ * DM * 2 <= 11 * MiB, "ws map");
constexpr int CW_TMO = 0, CW_CODE = 1, CW_BAR = 4096, CW_PREQ = 8192;

constexpr int RING_OFF = 0, RING_BYTES = 131072;
constexpr int LDSCTL_OFF = RING_BYTES, MISC_OFF = LDSCTL_OFF + 320;
constexpr int LDS_BYTES = 147456;

struct Frame {
    LAS unsigned char* lds; char* ldsg; volatile LAS unsigned* MISC; gu32* ctl; int tid, lane, wave, vcu, G;
    const float *xp, *xs, *cp, *cs, *ck, *cv, *clf, *st0; const int* pt;
    const float *ada_w, *ada_b, *n1pre, *n1post, *n2pre, *n2post, *w_in, *lbw, *onorm, *fxb, *w_brh, *w_brf, *w_out, *w_up, *w_dn;
    float* out; unsigned char* ws;
    bf16 *Win_t, *Wbh_t, *Wbf_t, *Wout_t, *Wup_t, *Wdn_t, *H, *QH, *VH, *SG, *QF, *KF, *VF, *MG, *OF, *OH, *MRG, *ACT;
    float *MOD, *G2, *T1, *Y, *U2; bf16* ws_qd; float* ws_oloc; float *slab_o, *slab_d;
};
__device__ __forceinline__ float wave_sum(float v) {
#pragma unroll
    for (int o = 1; o < 64; o <<= 1) v += __shfl_xor(v, o);
    return v;
}
__device__ __forceinline__ float bf2f(bf16 b) { return __uint_as_float((unsigned)b << 16); }
__device__ __forceinline__ float sigmoidf_(float x) { return __frcp_rn(1.0f + __expf(-x)); }
__device__ __forceinline__ const float* xrow(const Frame& F, int m) { return m < MP ? F.xp + (size_t)m * DM : F.xs + (size_t)(m - MP) * DM; }
__device__ __forceinline__ int modrow(int m) { return m < MP ? (m >> 11) : BP + ((m - MP) >> 3); }
__device__ __forceinline__ float* kout(const Frame& F, int m) { return m < MP ? F.out + O_KP + (size_t)m * FW : F.out + O_KS + (size_t)(m - MP) * FW; }
__device__ __forceinline__ float* vout(const Frame& F, int m) { return m < MP ? F.out + O_VP + (size_t)m * FW : F.out + O_VS + (size_t)(m - MP) * FW; }
__device__ __forceinline__ float* lfout(const Frame& F, int m) { return m < MP ? F.out + O_LFP + (size_t)m * FH : F.out + O_LFS + (size_t)(m - MP) * FH; }

__device__ __forceinline__ void tr_item(const float* W, int ldw, int K, int src_c0, bf16* WT, int dst_r0, LAS float* scr, int kb, int lane) {
    const int k0 = 64 * kb;
#pragma unroll 8
    for (int i = 0; i < 32; ++i) { const int kk = 2 * i + (lane >> 5); scr[kk * 33 + (lane & 31)] = W[(size_t)(k0 + kk) * ldw + src_c0 + (lane & 31)]; }
    LDS_WAIT(); asm volatile("" ::: "memory");
    const int c = lane & 7;
#pragma unroll
    for (int j = 0; j < 4; ++j) { const int n = (lane >> 3) + 8 * j; const LAS float* s = scr + (8 * c) * 33 + n;
        v4u o; o.x = pk2(s[0 * 33], s[1 * 33]); o.y = pk2(s[2 * 33], s[3 * 33]); o.z = pk2(s[4 * 33], s[5 * 33]); o.w = pk2(s[6 * 33], s[7 * 33]);
        *(GAS v4u*)(WT + (size_t)(dst_r0 + n) * K + k0 + 8 * c) = o; }
    LDS_WAIT(); asm volatile("" ::: "memory");
}
__device__ __forceinline__ float siluf_(float x) { return x * sigmoidf_(x); }
__device__ __forceinline__ void mod_task(Frame& F, int tsk) {
    const int lane = F.lane, w = F.wave, g = lane >> 4, n16 = lane & 15;
    const int ntile = 2 * tsk + (w >> 2), kq = w & 3, col = 16 * ntile + n16;
    f32x4 acc[9];
#pragma unroll
    for (int r = 0; r < 9; ++r) acc[r] = (f32x4){0.f, 0.f, 0.f, 0.f};
    for (int ks = 0; ks < 8; ++ks) {
        const int k0 = 256 * kq + 32 * ks + 8 * g;
        bf16x8 bfr;
#pragma unroll
        for (int j = 0; j < 8; ++j) bfr[j] = (short)f2bf(F.ada_w[(size_t)(k0 + j) * NMOD + col]);
#pragma unroll
        for (int rt = 0; rt < 9; ++rt) {
            const int row = 16 * rt + n16; bf16x8 afr = (bf16x8){0, 0, 0, 0, 0, 0, 0, 0};
            if (row < NMODR) { const float* c = (row < BP ? F.cp + (size_t)row * DM : F.cs + (size_t)(row - BP) * DM) + k0;
                const f32x4 c0 = *(const f32x4*)c, c1 = *(const f32x4*)(c + 4);
                afr[0] = (short)f2bf(siluf_(c0.x)); afr[1] = (short)f2bf(siluf_(c0.y)); afr[2] = (short)f2bf(siluf_(c0.z)); afr[3] = (short)f2bf(siluf_(c0.w));
                afr[4] = (short)f2bf(siluf_(c1.x)); afr[5] = (short)f2bf(siluf_(c1.y)); afr[6] = (short)f2bf(siluf_(c1.z)); afr[7] = (short)f2bf(siluf_(c1.w)); }
            acc[rt] = __builtin_amdgcn_mfma_f32_16x16x32_bf16(afr, bfr, acc[rt], 0, 0, 0);
        }
    }
    LAS f32x4* red = (LAS f32x4*)(F.lds + RING_OFF);
#pragma unroll
    for (int rt = 0; rt < 9; ++rt) red[(w * 9 + rt) * 64 + lane] = acc[rt];
    __syncthreads();
    if (kq == 0) {
        const float bias = F.ada_b[col];
#pragma unroll
        for (int rt = 0; rt < 9; ++rt) {
            f32x4 s = red[(w * 9 + rt) * 64 + lane] + red[((w + 1) * 9 + rt) * 64 + lane] + red[((w + 2) * 9 + rt) * 64 + lane] + red[((w + 3) * 9 + rt) * 64 + lane];
#pragma unroll
            for (int i = 0; i < 4; ++i) { const int row = 16 * rt + 4 * g + i; if (row < NMODR) F.MOD[(size_t)row * NMOD + col] = s[i] + bias; }
        }
    }
    __syncthreads();
}
__device__ __forceinline__ void p0_prologue(Frame& F) {
    for (int t = blockIdx.x; t < NMOD / 32; t += F.G) mod_task(F, t);
    LAS float* scr = (LAS float*)(F.lds + RING_OFF + F.wave * 16384);
    const int gw = F.vcu * NWAVES + F.wave, NGW = F.G * NWAVES;
    constexpr int I0 = 16 * 112, I1 = 16 * 64, I2 = 8 * 32, I3 = 8 * 32, I4 = 16 * 32, I5 = 16 * 128, I6 = 64 * 32;
    constexpr int NITEMS = I0 + I1 + I2 + I3 + I4 + I5 + I6;
    for (int it = gw; it < NITEMS; it += NGW) {
        int r = it;
        if (r < I0) { tr_item(F.w_in, INC, DM, 32 * (r % 112), F.Win_t, 32 * (r % 112), scr, r / 112, F.lane); continue; } r -= I0;
        if (r < I1) { tr_item(F.w_in, INC, DM, 3592 + 32 * (r % 64), F.Win_t, 3584 + 32 * (r % 64), scr, r / 64, F.lane); continue; } r -= I1;
        if (r < I2) { tr_item(F.w_brh, DM, HW, 32 * (r % 32), F.Wbh_t, 32 * (r % 32), scr, r / 32, F.lane); continue; } r -= I2;
        if (r < I3) { tr_item(F.w_brf, DM, FW, 32 * (r % 32), F.Wbf_t, 32 * (r % 32), scr, r / 32, F.lane); continue; } r -= I3;
        if (r < I4) { tr_item(F.w_out, DM, DM, 32 * (r % 32), F.Wout_t, 32 * (r % 32), scr, r / 32, F.lane); continue; } r -= I4;
        if (r < I5) { tr_item(F.w_up, DFF, DM, 32 * (r % 128), F.Wup_t, 32 * (r % 128), scr, r / 128, F.lane); continue; } r -= I5;
        tr_item(F.w_dn, DM, DFF, 32 * (r % 32), F.Wdn_t, 32 * (r % 32), scr, r / 32, F.lane);
    }
}

__device__ __forceinline__ void p1_norm1(Frame& F) {
    const int gw = F.vcu * NWAVES + F.wave, NGW = F.G * NWAVES, lane = F.lane;
    float wff[4][4][8];
#pragma unroll
    for (int j = 0; j < 4; ++j)
#pragma unroll
        for (int e = 0; e < 4; ++e) { const float* p = F.w_in + (size_t)(4 * lane + 256 * j + e) * INC + 3584; const f32x4 a = *(const f32x4*)p, b = *(const f32x4*)(p + 4);
            wff[j][e][0] = a.x; wff[j][e][1] = a.y; wff[j][e][2] = a.z; wff[j][e][3] = a.w; wff[j][e][4] = b.x; wff[j][e][5] = b.y; wff[j][e][6] = b.z; wff[j][e][7] = b.w; }
    f32x4 wn[4];
#pragma unroll
    for (int j = 0; j < 4; ++j) wn[j] = *(const f32x4*)(F.n1pre + 4 * lane + 256 * j);
    for (int m = gw; m < M; m += NGW) {
        const f32x4* xr = (const f32x4*)xrow(F, m) + lane; const float* mod = F.MOD + (size_t)modrow(m) * NMOD;
        f32x4 v[4]; float ss = 0.f;
#pragma unroll
        for (int j = 0; j < 4; ++j) { v[j] = xr[64 * j]; ss += (v[j].x * v[j].x + v[j].y * v[j].y) + (v[j].z * v[j].z + v[j].w * v[j].w); }
        const float rinv = 1.0f / sqrtf(wave_sum(ss) * (1.f / DM) + RMS_EPS);
        float ff[8];
#pragma unroll
        for (int q = 0; q < 8; ++q) ff[q] = 0.f;
        unsigned long long* o8 = (unsigned long long*)(F.H + (size_t)m * DM) + lane;
#pragma unroll
        for (int j = 0; j < 4; ++j) {
            const f32x4 sh = *(const f32x4*)(mod + 4 * lane + 256 * j), sc = *(const f32x4*)(mod + DM + 4 * lane + 256 * j);
            const f32x4 h = v[j] * rinv * wn[j] * (sc + 1.0f) + sh;
            o8[64 * j] = (unsigned long long)pk2(h.x, h.y) | ((unsigned long long)pk2(h.z, h.w) << 32);
#pragma unroll
            for (int q = 0; q < 8; ++q) ff[q] += (h.x * wff[j][0][q] + h.y * wff[j][1][q]) + (h.z * wff[j][2][q] + h.w * wff[j][3][q]);
        }
#pragma unroll
        for (int q = 0; q < 8; ++q) ff[q] = wave_sum(ff[q]);
        float z = ff[0];
#pragma unroll
        for (int q = 1; q < 8; ++q) z = (lane == q) ? ff[q] : z;
        if (lane < 8) { z += F.fxb[lane]; lfout(F, m)[lane] = fminf(z, 0.f) - log1pf(expf(-fabsf(z))); }
    }
}

typedef unsigned u32x4_t __attribute__((ext_vector_type(4)));
__device__ __forceinline__ u32x4_t pack8(const f32x4& a, const f32x4& b) { u32x4_t w; w.x = pg8::cvt_pk_bf16(a[0], a[1]); w.y = pg8::cvt_pk_bf16(a[2], a[3]); w.z = pg8::cvt_pk_bf16(b[0], b[1]); w.w = pg8::cvt_pk_bf16(b[2], b[3]); return w; }
__device__ __forceinline__ void unpack8(const u32x4_t w, f32x4& a, f32x4& b) {
    a[0] = __uint_as_float(w.x << 16); a[1] = __uint_as_float(w.x & 0xffff0000u); a[2] = __uint_as_float(w.y << 16); a[3] = __uint_as_float(w.y & 0xffff0000u);
    b[0] = __uint_as_float(w.z << 16); b[1] = __uint_as_float(w.z & 0xffff0000u); b[2] = __uint_as_float(w.w << 16); b[3] = __uint_as_float(w.w & 0xffff0000u); }

__device__ __forceinline__ f32x4 sig4(const f32x4 v) { return (f32x4){sigmoidf_(v[0]), sigmoidf_(v[1]), sigmoidf_(v[2]), sigmoidf_(v[3])}; }
__device__ __forceinline__ f32x4 silu4(const f32x4 v) { return v * sig4(v); }
__device__ __forceinline__ f32x4 relu2_4(const f32x4 v) { const f32x4 r = (f32x4){fmaxf(v[0], 0.f), fmaxf(v[1], 0.f), fmaxf(v[2], 0.f), fmaxf(v[3], 0.f)}; return r * r; }
__device__ __forceinline__ f32x4 g2_4(const f32x4 x, const f32x4 l0, const f32x4 l1) { f32x4 r;
    _Pragma("unroll") for (int e = 0; e < 4; ++e) { const float lb = __frcp_rn(1.0f + __expf(l1[e] - l0[e])); r[e] = __log2f(lb + (1.0f - lb) * sigmoidf_(x[e])); } return r; }
#define EPI_FOREACH(...) \
    const int row0_ = u.pm * pg8::BM + wr * 64 + fr, colb_ = u.pn * pg8::BM + wc * 32 + 8 * fq; \
    _Pragma("unroll") for (int ai = 0; ai < 2; ++ai) _Pragma("unroll") for (int m = 0; m < 4; ++m) { const int row = row0_ + ai * pg8::HALF + m * 16; \
        _Pragma("unroll") for (int bj = 0; bj < 2; ++bj) { const int col = colb_ + bj * pg8::HALF; f32x4 v0 = acc[ai][bj][m][0], v1 = acc[ai][bj][m][1]; __VA_ARGS__ } }

struct EpiProj {
    static constexpr bool PERM = true, AFTER_DRAIN = false, KEEPS = false;
    bf16 *QH, *VH, *SG, *QF, *KF, *VF, *MG; float* G2; float* out; const float* lbw;
    __device__ __forceinline__ void operator()(const f32x4 (&acc)[2][2][4][2], const pg8::Unit& u, int wr, int wc, int fr, int fq) const {
        const int seg = u.pn >> 1;
        if (u.pn >= 14) { EPI_FOREACH( *(u32x4_t*)(MG + (size_t)row * 2048 + (col - 3584)) = pack8(sig4(v0), sig4(v1)); ) }
        else if (seg == 0) { EPI_FOREACH( *(u32x4_t*)(QH + (size_t)row * HW + col) = pack8(v0 * HQ_SCALE, v1 * HQ_SCALE); ) }
        else if (seg == 1) {
            EPI_FOREACH( const int k = col - 512;
                *(f32x4*)(G2 + (size_t)row * HW + k) = g2_4(v0, *(const f32x4*)(lbw + k), *(const f32x4*)(lbw + HW + k));
                *(f32x4*)(G2 + (size_t)row * HW + k + 4) = g2_4(v1, *(const f32x4*)(lbw + k + 4), *(const f32x4*)(lbw + HW + k + 4)); ) }
        else if (seg == 2) { EPI_FOREACH( *(u32x4_t*)(VH + (size_t)row * HW + (col - 1024)) = pack8(v0, v1); ) }
        else if (seg == 3) { EPI_FOREACH( *(u32x4_t*)(SG + (size_t)row * HW + (col - 1536)) = pack8(silu4(v0), silu4(v1)); ) }
        else if (seg == 4) { EPI_FOREACH( *(u32x4_t*)(QF + (size_t)row * FW + (col - 2048)) = pack8(v0 * C2, v1 * C2); ) }
        else if (seg == 5) { EPI_FOREACH( const int c = col - 2560; *(u32x4_t*)(KF + (size_t)row * FW + c) = pack8(v0, v1);
                float* o = (row < MP ? out + O_KP + (size_t)row * FW : out + O_KS + (size_t)(row - MP) * FW) + c; *(f32x4*)o = v0; *(f32x4*)(o + 4) = v1; ) }
        else { EPI_FOREACH( const int c = col - 3072; *(u32x4_t*)(VF + (size_t)row * FW + c) = pack8(v0, v1);
                float* o = (row < MP ? out + O_VP + (size_t)row * FW : out + O_VS + (size_t)(row - MP) * FW) + c; *(f32x4*)o = v0; *(f32x4*)(o + 4) = v1; ) }
    }
};
struct EpiBrH {
    static constexpr bool PERM = true, AFTER_DRAIN = false, KEEPS = false; const bf16* MG; float* T1;
    __device__ __forceinline__ void operator()(const f32x4 (&acc)[2][2][4][2], const pg8::Unit& u, int wr, int wc, int fr, int fq) const {
        EPI_FOREACH( f32x4 ga, gb; unpack8(*(const u32x4_t*)(MG + (size_t)row * 2048 + col), ga, gb); *(f32x4*)(T1 + (size_t)row * DM + col) = v0 * ga; *(f32x4*)(T1 + (size_t)row * DM + col + 4) = v1 * gb; ) }
};
struct EpiBrF {
    static constexpr bool PERM = true, AFTER_DRAIN = false, KEEPS = false; const bf16* MG; const float* T1; bf16* MRG;
    __device__ __forceinline__ void operator()(const f32x4 (&acc)[2][2][4][2], const pg8::Unit& u, int wr, int wc, int fr, int fq) const {
        EPI_FOREACH( f32x4 ga, gb; unpack8(*(const u32x4_t*)(MG + (size_t)row * 2048 + DM + col), ga, gb);
            const f32x4 t0 = *(const f32x4*)(T1 + (size_t)row * DM + col), t1 = *(const f32x4*)(T1 + (size_t)row * DM + col + 4);
            *(u32x4_t*)(MRG + (size_t)row * DM + col) = pack8(t0 + v0 * ga, t1 + v1 * gb); ) }
};
struct EpiF32 {
    static constexpr bool PERM = true, AFTER_DRAIN = false, KEEPS = false; float* O; int ldc;
    __device__ __forceinline__ void operator()(const f32x4 (&acc)[2][2][4][2], const pg8::Unit& u, int wr, int wc, int fr, int fq) const {
        EPI_FOREACH( *(f32x4*)(O + (size_t)row * ldc + col) = v0; *(f32x4*)(O + (size_t)row * ldc + col + 4) = v1; ) }
};
struct EpiRelu2 {
    static constexpr bool PERM = true, AFTER_DRAIN = false, KEEPS = false; bf16* O; int ldc;
    __device__ __forceinline__ void operator()(const f32x4 (&acc)[2][2][4][2], const pg8::Unit& u, int wr, int wc, int fr, int fq) const {
        EPI_FOREACH( *(u32x4_t*)(O + (size_t)row * ldc + col) = pack8(relu2_4(v0), relu2_4(v1)); ) }
};


struct EpiSlab {
    static constexpr bool PERM = true, AFTER_DRAIN = false, KEEPS = false; float* slab;
    __device__ __forceinline__ void operator()(const f32x4 (&acc)[2][2][4][2], const pg8::Unit& u, int wr, int wc, int fr, int fq) const {
        float* O = slab + (size_t)u.aux * MS * DM - (size_t)MP * DM;
        EPI_FOREACH( *(f32x4*)(O + (size_t)row * DM + col) = v0; *(f32x4*)(O + (size_t)row * DM + col + 4) = v1; ) }
};
struct PieceOrder {
    int np, S, kp, G, c, pm0, nN;
    __device__ __forceinline__ bool next(int i, pg8::Unit& u) const { const int L = i * G + c; if (L >= np) return false; const int t = L / S, ks = L % S;
        u.pm = pm0 + t / nN; u.pn = t % nN; u.sel = 0; u.koff = ks * kp; u.aux = ks; return true; }
    __device__ __forceinline__ void a_ready(const pg8::Unit&) const {}
    __device__ __forceinline__ void done(const pg8::Unit&) const {}
};


constexpr int PROJ_NS = 88, PROJ_NPRE = 24, PROJ_NU = 68 * 22;
struct ProjOrder {
    int G, c, i0, i1; unsigned* cnt;
    __device__ __forceinline__ bool next(int i, pg8::Unit& u) const {
        const int r = i0 + i; if (r >= i1) return false; const int L = r * G + c; if (L >= PROJ_NU) return false;
        u.sel = 0; u.koff = 0; u.aux = 0;
        if (L < PROJ_NS) { int pn; if (L < PROJ_NPRE) pn = 8 + (L >> 2); else { const int q = (L - PROJ_NPRE) >> 2; pn = q < 8 ? q : q + 6; } u.pm = MP / 256 + (L & 3); u.pn = pn; return true; }
        constexpr int nM = MP / 256, nN = NPROJ / 256, nwg = nM * nN;
        int wgid = L - PROJ_NS; { const int q = nwg / 8, rr = nwg % 8, xcd = wgid % 8, off = wgid / 8; wgid = (xcd < rr ? xcd * (q + 1) : rr * (q + 1) + (xcd - rr) * q) + off; }
        const int nig = 8 * nN, gid = wgid / nig, fm = gid * 8, gsz = (nM - fm) < 8 ? (nM - fm) : 8;
        u.pm = fm + ((wgid % nig) % gsz); u.pn = (wgid % nig) / gsz; return true;
    }
    __device__ __forceinline__ void a_ready(const pg8::Unit&) const {}
    __device__ __forceinline__ void done(const pg8::Unit& u) const {
        if (u.pm >= MP / 256 && u.pn >= 8 && u.pn <= 13) {
            asm volatile("s_waitcnt vmcnt(0)" ::: "memory");
            __builtin_amdgcn_fence(__ATOMIC_RELEASE, "agent");
            asm volatile("s_waitcnt vmcnt(0)" ::: "memory");
            if ((threadIdx.x & 63) == 0) __hip_atomic_fetch_add(cnt, 1u, __ATOMIC_RELAXED, __HIP_MEMORY_SCOPE_AGENT);
        }
    }
};
__device__ __forceinline__ void wait_proj_prereq(Frame& F, unsigned* cnt) {
    if (F.wave == 0) {
        const unsigned long long t0 = __builtin_amdgcn_s_memrealtime();
        for (;;) {
            if ((unsigned)__builtin_amdgcn_readfirstlane(__hip_atomic_load(cnt, __ATOMIC_RELAXED, __HIP_MEMORY_SCOPE_AGENT)) >= (unsigned)(PROJ_NPRE * NWAVES)) break;
            if (__builtin_amdgcn_s_memrealtime() - t0 > 2000000ull) { if (F.lane == 0) __hip_atomic_store((unsigned*)(F.ctl + CW_TMO), 0x5A01u, __ATOMIC_RELAXED, __HIP_MEMORY_SCOPE_AGENT); break; }
            __builtin_amdgcn_s_sleep(8);
        }
        __builtin_amdgcn_fence(__ATOMIC_ACQUIRE, "agent");
        asm volatile("s_waitcnt vmcnt(0)" ::: "memory");
    }
    __syncthreads();
}

__device__ __forceinline__ void p8_midnorm(Frame& F) {
    const int gw = F.vcu * NWAVES + F.wave, NGW = F.G * NWAVES, lane = F.lane;
    f32x4 wpost[4], wpre[4];
#pragma unroll
    for (int j = 0; j < 4; ++j) { wpost[j] = *(const f32x4*)(F.n1post + 4 * lane + 256 * j); wpre[j] = *(const f32x4*)(F.n2pre + 4 * lane + 256 * j); }
    constexpr int NA = 7, NB = 9; const bool deal = (NGW == 2048);
    const int nit = deal ? (gw < 1024 ? 1 + NA : NB) : (M - gw + NGW - 1) / NGW;
    for (int it = 0; it < nit; ++it) {
        const int m = deal ? (gw < 1024 ? (it == 0 ? MP + gw : gw + 1024 * (it - 1)) : NA * 1024 + (gw - 1024) + 1024 * it) : gw + it * NGW;
        const f32x4* xr = (const f32x4*)xrow(F, m) + lane; const f32x4* yr = (const f32x4*)(F.Y + (size_t)m * DM) + lane; const float* mod = F.MOD + (size_t)modrow(m) * NMOD;
        f32x4 y[4], x1[4]; float ss = 0.f;
        if (m >= MP) { const f32x4* sl = (const f32x4*)(F.slab_o + (size_t)(m - MP) * DM) + lane;
#pragma unroll
            for (int j = 0; j < 4; ++j) y[j] = (sl[64 * j] + sl[64 * j + (size_t)MS * DM / 4]) + (sl[64 * j + 2 * (size_t)MS * DM / 4] + sl[64 * j + 3 * (size_t)MS * DM / 4]);
        } else {
#pragma unroll
            for (int j = 0; j < 4; ++j) y[j] = yr[64 * j];
        }
#pragma unroll
        for (int j = 0; j < 4; ++j) { ss += (y[j].x * y[j].x + y[j].y * y[j].y) + (y[j].z * y[j].z + y[j].w * y[j].w); }
        const float rinv = 1.0f / sqrtf(wave_sum(ss) * (1.f / DM) + RMS_EPS);
        float s2 = 0.f; f32x4* o4 = (f32x4*)(F.out + O_Y + (size_t)m * DM) + lane;
#pragma unroll
        for (int j = 0; j < 4; ++j) { const f32x4 gt = *(const f32x4*)(mod + 2 * DM + 4 * lane + 256 * j);
            x1[j] = xr[64 * j] + gt * (y[j] * rinv * wpost[j]); o4[64 * j] = x1[j];
            s2 += (x1[j].x * x1[j].x + x1[j].y * x1[j].y) + (x1[j].z * x1[j].z + x1[j].w * x1[j].w); }
        const float r2 = 1.0f / sqrtf(wave_sum(s2) * (1.f / DM) + RMS_EPS);
        unsigned long long* o8 = (unsigned long long*)(F.H + (size_t)m * DM) + lane;
#pragma unroll
        for (int j = 0; j < 4; ++j) { const f32x4 sh = *(const f32x4*)(mod + 3 * DM + 4 * lane + 256 * j), sc = *(const f32x4*)(mod + 4 * DM + 4 * lane + 256 * j);
            const f32x4 h = x1[j] * r2 * wpre[j] * (sc + 1.0f) + sh;
            o8[64 * j] = (unsigned long long)pk2(h.x, h.y) | ((unsigned long long)pk2(h.z, h.w) << 32); }
    }
}
__device__ __forceinline__ void p11_final(Frame& F) {
    const int gw = F.vcu * NWAVES + F.wave, NGW = F.G * NWAVES, lane = F.lane;
    f32x4 wpost[4];
#pragma unroll
    for (int j = 0; j < 4; ++j) wpost[j] = *(const f32x4*)(F.n2post + 4 * lane + 256 * j);
    constexpr int NA = 6, NB = 10; const bool deal = (NGW == 2048);
    const int nit = deal ? (gw < 1024 ? 1 + NA : NB) : (M - gw + NGW - 1) / NGW;
    for (int it = 0; it < nit; ++it) {
        const int m = deal ? (gw < 1024 ? (it == 0 ? MP + gw : gw + 1024 * (it - 1)) : NA * 1024 + (gw - 1024) + 1024 * it) : gw + it * NGW;
        const f32x4* ur = (const f32x4*)(F.U2 + (size_t)m * DM) + lane; const float* mod = F.MOD + (size_t)modrow(m) * NMOD;
        f32x4 uu[4]; float ss = 0.f;
        if (m >= MP) { const f32x4* sl = (const f32x4*)(F.slab_d + (size_t)(m - MP) * DM) + lane;
            constexpr size_t SS = (size_t)MS * DM / 4;
#pragma unroll
            for (int j = 0; j < 4; ++j) uu[j] = ((sl[64 * j] + sl[64 * j + SS]) + (sl[64 * j + 2 * SS] + sl[64 * j + 3 * SS])) + ((sl[64 * j + 4 * SS] + sl[64 * j + 5 * SS]) + (sl[64 * j + 6 * SS] + sl[64 * j + 7 * SS]));
        } else {
#pragma unroll
            for (int j = 0; j < 4; ++j) uu[j] = ur[64 * j];
        }
#pragma unroll
        for (int j = 0; j < 4; ++j) { ss += (uu[j].x * uu[j].x + uu[j].y * uu[j].y) + (uu[j].z * uu[j].z + uu[j].w * uu[j].w); }
        const float rinv = 1.0f / sqrtf(wave_sum(ss) * (1.f / DM) + RMS_EPS);
        f32x4* o4 = (f32x4*)(F.out + O_Y + (size_t)m * DM) + lane;
#pragma unroll
        for (int j = 0; j < 4; ++j) { const f32x4 gt = *(const f32x4*)(mod + 5 * DM + 4 * lane + 256 * j); o4[64 * j] = o4[64 * j] + gt * (uu[j] * rinv * wpost[j]); }
    }
}
#include <hip/hip_bf16.h>
#include <cmath>
namespace attn_body {
using bf16=__hip_bfloat16;
using bf16x8=__attribute__((ext_vector_type(8)))short;
using s16x4=__attribute__((ext_vector_type(4)))short;
using f32x16=__attribute__((ext_vector_type(16)))float;
using u32x4=__attribute__((ext_vector_type(4)))unsigned;
constexpr int BATCH=8,NHEAD=8,SEQ=2048,D=64,DM=NHEAD*D;
constexpr int NW=8,QBLK=32,QB=QBLK*NW,KVBLK=64,NQB=SEQ/QB;
constexpr int ATTN_PITCH=DM, ATTN_UNIT_ROWS=QB;
__device__ __forceinline__ int crow(int r,int hi){return (r&3)+8*(r>>2)+4*hi;}
#define SBAR() __builtin_amdgcn_sched_barrier(0)
__device__ __forceinline__ void cmask(f32x16&p0,f32x16&p1,int jb,int qrel,int hi){
  const float NEG=-INFINITY; const int thr=qrel-64*jb-4*hi;
  #pragma unroll
  for(int r=0;r<16;++r){const int c=(r&3)+8*(r>>2); if(c>thr)p0[r]=NEG; if(c+32>thr)p1[r]=NEG;}
}
constexpr int NSLOT=3, SLOTB=8192;
constexpr int LDS_K=0, LDS_V=NSLOT*SLOTB, LDS_WS=2*NSLOT*SLOTB, LDS_OST=LDS_WS+NW*64*4, LDS_BIAS=LDS_OST+NW*4096, LDS_BYTES=LDS_BIAS+SEQ*4;
constexpr float C2=0.125f*1.4426950408889634f;
__device__ __forceinline__ void glds16(const void*gsrc,unsigned lds_dst){unsigned keep;
  asm volatile("s_mov_b32 %0, m0\n\ts_mov_b32 m0, %2\n\ts_nop 0\n\tglobal_load_lds_dwordx4 %1, off\n\ts_mov_b32 m0, %0":"=&s"(keep):"v"(gsrc),"s"(lds_dst):"memory");}
__device__ __forceinline__ float max3f(float a,float b,float c){float r;asm("v_max3_f32 %0, %1, %2, %3":"=v"(r):"v"(a),"v"(b),"v"(c));return r;}
__device__ __forceinline__ float max2f(float a,float b){float r;asm("v_max_f32_e32 %0, %1, %2":"=v"(r):"v"(a),"v"(b));return r;}
__device__ __forceinline__ float fadd_s(float a,float b){float r;asm("v_add_f32_e32 %0, %1, %2":"=v"(r):"v"(a),"v"(b));return r;}
__device__ __forceinline__ float fsub_s(float a,float b){float r;asm("v_sub_f32_e32 %0, %1, %2":"=v"(r):"v"(a),"v"(b));return r;}
typedef float fx4 __attribute__((ext_vector_type(4))); typedef float f32x2_t __attribute__((ext_vector_type(2))); typedef __bf16 bf16x2_t __attribute__((ext_vector_type(2)));
__device__ __forceinline__ unsigned cvtpk_s(float lo,float hi){f32x2_t v={lo,hi};bf16x2_t b=__builtin_convertvector(v,bf16x2_t);return __builtin_bit_cast(unsigned,b);}
#define WAIT_BAR(N) asm volatile("s_waitcnt vmcnt(" #N ") lgkmcnt(0)\n\ts_barrier":::"memory")

__device__ __forceinline__ void qkt(f32x16&p0,f32x16&p1,const char*Kslot,const bf16x8*qr,int r32,int hi){
  const char*kb=Kslot+hi*1024+r32*16;
  #pragma unroll
  for(int d0=0;d0<4;++d0){
    const bf16x8 b0=*reinterpret_cast<const bf16x8*>(kb+d0*2048);
    const bf16x8 b1=*reinterpret_cast<const bf16x8*>(kb+d0*2048+512);
    if(d0==0){p0=__builtin_amdgcn_mfma_f32_32x32x16_bf16(b0,qr[0],p0,0,0,0);p1=__builtin_amdgcn_mfma_f32_32x32x16_bf16(b1,qr[0],p1,0,0,0);}
    else{p0=__builtin_amdgcn_mfma_f32_32x32x16_bf16(b0,qr[d0],p0,0,0,0);p1=__builtin_amdgcn_mfma_f32_32x32x16_bf16(b1,qr[d0],p1,0,0,0);}}
}
typedef __attribute__((address_space(3))) const char* lds_cptr;
typedef short v4i16_t __attribute__((ext_vector_type(4)));
__device__ __forceinline__ void kload8(bf16x8*kf,lds_cptr kp){
  kf[0]=*(const __attribute__((address_space(3))) bf16x8*)(kp);      kf[1]=*(const __attribute__((address_space(3))) bf16x8*)(kp+512);
  kf[2]=*(const __attribute__((address_space(3))) bf16x8*)(kp+2048); kf[3]=*(const __attribute__((address_space(3))) bf16x8*)(kp+2560);
  kf[4]=*(const __attribute__((address_space(3))) bf16x8*)(kp+4096); kf[5]=*(const __attribute__((address_space(3))) bf16x8*)(kp+4608);
  kf[6]=*(const __attribute__((address_space(3))) bf16x8*)(kp+6144); kf[7]=*(const __attribute__((address_space(3))) bf16x8*)(kp+6656);
}
__device__ __forceinline__ void kload2(bf16x8*kf,lds_cptr kp,int j){ kf[2*j]=*(const __attribute__((address_space(3))) bf16x8*)(kp+j*2048); kf[2*j+1]=*(const __attribute__((address_space(3))) bf16x8*)(kp+j*2048+512); }
__device__ __forceinline__ s16x4 vtr(lds_cptr p){ return __builtin_bit_cast(s16x4,__builtin_amdgcn_ds_read_tr16_b64_v4i16((__attribute__((address_space(3))) v4i16_t*)p)); }
__device__ __forceinline__ float rowmax(const f32x16&p0,const f32x16&p1){
  float a=max3f(p0[0],p0[1],p1[0]),b=max3f(p0[2],p0[3],p1[1]);a=max3f(a,p1[2],p1[3]);
  #pragma unroll
  for(int r=4;r<16;r+=4){a=max3f(a,p0[r],p0[r+1]);b=max3f(b,p0[r+2],p0[r+3]);a=max3f(a,p1[r],p1[r+1]);b=max3f(b,p1[r+2],p1[r+3]);}
  const float m=max2f(a,b);
  auto rr=__builtin_amdgcn_permlane32_swap(__float_as_uint(m),__float_as_uint(m),false,false);
  return max2f(__uint_as_float(rr[0]),__uint_as_float(rr[1]));
}
__device__ __forceinline__ void pv(f32x16*o,int vb,bf16x8 pa0,bf16x8 pa1,bf16x8 pa2,bf16x8 pa3){
  #pragma unroll
  for(int d0=0;d0<2;++d0){s16x4 lo[4],hi[4];
    #pragma unroll
    for(int ks=0;ks<4;++ks){
      asm volatile("ds_read_b64_tr_b16 %0,%1 offset:%c2":"=&v"(lo[ks]):"v"(vb),"i"(d0*4096+ks*1024):"memory");
      asm volatile("ds_read_b64_tr_b16 %0,%1 offset:%c2":"=&v"(hi[ks]):"v"(vb),"i"(d0*4096+ks*1024+512):"memory");}
    asm volatile("s_waitcnt lgkmcnt(0)":::"memory");SBAR();
    #define PK(k) (bf16x8){lo[k][0],lo[k][1],lo[k][2],lo[k][3],hi[k][0],hi[k][1],hi[k][2],hi[k][3]}
    o[d0]=__builtin_amdgcn_mfma_f32_32x32x16_bf16(pa0,PK(0),o[d0],0,0,0);
    o[d0]=__builtin_amdgcn_mfma_f32_32x32x16_bf16(pa1,PK(1),o[d0],0,0,0);
    o[d0]=__builtin_amdgcn_mfma_f32_32x32x16_bf16(pa2,PK(2),o[d0],0,0,0);
    o[d0]=__builtin_amdgcn_mfma_f32_32x32x16_bf16(pa3,PK(3),o[d0],0,0,0);
    #undef PK
  }
}

#ifndef ATTN_STORE16
#define ATTN_STORE16(p,v) (*(u32x4*)(p)=(v))
#endif
template<int THRL> __device__ __forceinline__ void attn_unit(int b,int h,int qb,const bf16*Q,const bf16*__restrict__ K,const bf16*__restrict__ V,bf16*O,char*shm){
  const int tid=threadIdx.x,lane=tid&63,r32=lane&31,hi=lane>>5; const int wid=__builtin_amdgcn_readfirstlane(tid>>6);
  const long rowbase=(long)b*SEQ; const int q0=qb*QB;
  const bf16*Qw=Q+(rowbase+q0+wid*QBLK)*DM+h*D;
  const bf16*Kh=K+rowbase*DM+h*D,*Vh=V+rowbase*DM+h*D;
  const unsigned lds0=(unsigned)(uintptr_t)shm;
  float*wsf=(float*)(shm+LDS_WS)+wid*64;
  const bf16*ksrc=Kh+(long)lane*DM+wid*8;
  const bf16*vsrc=Vh+(long)(16*(wid&3)+(lane>>2))*DM+(wid>>2)*32+(lane&3)*8;
  const unsigned kdst=lds0+LDS_K+wid*1024, vdst=lds0+LDS_V+wid*1024;
  #define DMA_K(t,slot) glds16(ksrc+(long)(t)*KVBLK*DM,(unsigned)__builtin_amdgcn_readfirstlane(kdst+(slot)))
  #define DMA_V(t,slot) glds16(vsrc+(long)(t)*KVBLK*DM,(unsigned)__builtin_amdgcn_readfirstlane(vdst+(slot)))
  const int vb0=(int)(lds0+LDS_V)+((lane>>4)&1)*32+(lane&3)*8+(4*hi+((lane&15)>>2))*64;
  const char*Kbase=shm+LDS_K; bf16x8 kf[8];
  const lds_cptr shm3=(lds_cptr)shm; const lds_cptr kp0=shm3+LDS_K+hi*1024+r32*16; const lds_cptr vp0=shm3+LDS_V+((lane>>4)&1)*32+(lane&3)*8+(4*hi+((lane&15)>>2))*64;
  const int NT=(q0+QB)/KVBLK;
  DMA_K(0,0);DMA_V(0,0);DMA_K(1,SLOTB);
  bf16x8 qr[4];
  #pragma unroll
  for(int d0=0;d0<4;++d0)qr[d0]=*reinterpret_cast<const bf16x8*>(&Qw[(long)r32*DM+d0*16+hi*8]);
  float mhat=0.f,l_reg=0.f;f32x16 o[2];o[0]=f32x16{};o[1]=f32x16{};
  const int qrel=wid*QBLK+r32;
  #define CMASK(P0,P1,t) do{int jb_=(t)-(NT-4); if(jb_>=0)cmask(P0,P1,jb_,qrel,hi);}while(0)
  const __attribute__((address_space(3))) float* biasp=(const __attribute__((address_space(3))) float*)(shm3+LDS_BIAS)+4*hi;
  #define INITC(P0,P1,t) do{ const __attribute__((address_space(3))) float* bp_=biasp+64*(t); \
    _Pragma("unroll") for(int g_=0;g_<4;++g_){ const fx4 b0_=*(const __attribute__((address_space(3))) fx4*)(bp_+8*g_); \
      _Pragma("unroll") for(int e_=0;e_<4;++e_) P0[4*g_+e_]=b0_[e_]-mhat; } \
    _Pragma("unroll") for(int g_=0;g_<4;++g_){ const fx4 b1_=*(const __attribute__((address_space(3))) fx4*)(bp_+32+8*g_); \
      _Pragma("unroll") for(int e_=0;e_<4;++e_) P1[4*g_+e_]=b1_[e_]-mhat; } }while(0)
  bool resc=false;
  #define START(P0,P1) do{ const float rm=rowmax(P0,P1); resc=false; \
    { const float dl=rm; mhat=fadd_s(mhat,dl); \
      _Pragma("unroll") for(int r=0;r<16;++r){P0[r]=fsub_s(P0[r],dl);P1[r]=fsub_s(P1[r],dl);} \
      } \
    _Pragma("unroll") for(int r=0;r<16;++r)P0[r]=__builtin_amdgcn_exp2f(P0[r]); }while(0)
  #define RESC() do{ if(resc){ asm volatile("s_waitcnt lgkmcnt(0)":::"memory"); \
      _Pragma("unroll") for(int d_=0;d_<2;++d_) _Pragma("unroll") for(int r=0;r<16;++r)o[d_][r]*=wsf[crow(r,hi)]; } }while(0)
  f32x16 pA0,pA1,pB0,pB1;
  int sl_prev=0,sl_cur=0,sl_next=SLOTB;
  #define ROT() do{sl_prev=sl_cur;sl_cur=sl_next;sl_next=(sl_next==(NSLOT-1)*SLOTB)?0:sl_next+SLOTB;}while(0)
  DMA_K(2,2*SLOTB);
  WAIT_BAR(3);
  INITC(pA0,pA1,0);qkt(pA0,pA1,Kbase,qr,r32,hi);asm volatile("s_nop 15\n\ts_nop 7":"+v"(pA0),"+v"(pA1));CMASK(pA0,pA1,0);
  START(pA0,pA1);
  _Pragma("unroll") for(int r=0;r<16;++r)pA1[r]=__builtin_amdgcn_exp2f(pA1[r]);
  WAIT_BAR(0);
  DMA_K(3,0);DMA_V(1,SLOTB);
  ROT();
  kload8(kf,kp0+sl_cur);
  WAIT_BAR(2);
  s16x4 vlo[8],vhi[8]; u32x4 pw0,pw1,pw2,pw3;
  #define PKW(P,B) cvtpk_s(P[B],P[B+1])
  #define PAF(k) __builtin_bit_cast(bf16x8,pw##k)
  #define VFR(i) (bf16x8){vlo[i][0],vlo[i][1],vlo[i][2],vlo[i][3],vhi[i][0],vhi[i][1],vhi[i][2],vhi[i][3]}
  #define PIN(x) asm volatile("":"+v"(x))
  #define MX3(a,b,c) __builtin_fmaxf(__builtin_fmaxf((a),(b)),(c))
  #define GAPA(MF,A0,A1,A2,A3,W0,W1,PW) do{ MF; sacc+=A0; sacc+=A1; sacc+=A2; sacc+=A3; PIN(sacc); W0; W1; PIN(PW); SBAR(); }while(0)
  #define EX(v) __builtin_amdgcn_exp2f(v)
  #define GAPB(MF,X,B) do{ MF; X[B]=EX(X[B]); X[B+1]=EX(X[B+1]); X[B+2]=EX(X[B+2]); X[B+3]=EX(X[B+3]); PIN(X); SBAR(); }while(0)
  #define VRD(i) do{ vlo[i]=vtr(vp_+(((i)>>2)*4096+((i)&3)*1024)); vhi[i]=vtr(vp_+(((i)>>2)*4096+((i)&3)*1024+512)); }while(0)
  #define KRD(G,j) do{ if(G){ kload2(kf,kp0+sl_next,j); SBAR(); } }while(0)
  #define STEP(C0,C1,P0,P1,t,GK,GV,GL) do{ SBAR(); INITC(C0,C1,t); SBAR(); \
    const lds_cptr vp_=vp0+sl_prev; \
    VRD(0); SBAR(); float sacc=(P0[0]+P0[1]); \
    GAPA(C0=__builtin_amdgcn_mfma_f32_32x32x16_bf16(kf[0],qr[0],C0,0,0,0), P0[2],P0[3],P0[4],P0[5],     pw0[0]=PKW(P0,0), pw0[1]=PKW(P0,2), pw0); \
    VRD(4); SBAR(); GAPA(C1=__builtin_amdgcn_mfma_f32_32x32x16_bf16(kf[1],qr[0],C1,0,0,0), P0[6],P0[7],P0[8],P0[9],     pw0[2]=PKW(P0,4), pw0[3]=PKW(P0,6), pw0); \
    VRD(1); SBAR(); GAPA(C0=__builtin_amdgcn_mfma_f32_32x32x16_bf16(kf[2],qr[1],C0,0,0,0),   P0[10],P0[11],P0[12],P0[13], pw1[0]=PKW(P0,8), pw1[1]=PKW(P0,10), pw1); \
    VRD(5); SBAR(); GAPA(C1=__builtin_amdgcn_mfma_f32_32x32x16_bf16(kf[3],qr[1],C1,0,0,0),   P0[14],P0[15],P1[0],P1[1],   pw1[2]=PKW(P0,12),pw1[3]=PKW(P0,14), pw1); \
    VRD(2); SBAR(); GAPA(C0=__builtin_amdgcn_mfma_f32_32x32x16_bf16(kf[4],qr[2],C0,0,0,0),   P1[2],P1[3],P1[4],P1[5],     pw2[0]=PKW(P1,0), pw2[1]=PKW(P1,2), pw2); \
    VRD(6); SBAR(); GAPA(C1=__builtin_amdgcn_mfma_f32_32x32x16_bf16(kf[5],qr[2],C1,0,0,0),   P1[6],P1[7],P1[8],P1[9],     pw2[2]=PKW(P1,4), pw2[3]=PKW(P1,6), pw2); \
    VRD(3); SBAR(); GAPA(C0=__builtin_amdgcn_mfma_f32_32x32x16_bf16(kf[6],qr[3],C0,0,0,0),   P1[10],P1[11],P1[12],P1[13], pw3[0]=PKW(P1,8), pw3[1]=PKW(P1,10), pw3); \
    VRD(7); SBAR(); GAPA(C1=__builtin_amdgcn_mfma_f32_32x32x16_bf16(kf[7],qr[3],C1,0,0,0),   P1[14],P1[15],0.f,0.f,       pw3[2]=PKW(P1,12),pw3[3]=PKW(P1,14), pw3); \
    l_reg+=sacc; \
    if(GK){DMA_K((t)+3,sl_cur);} if(GV){DMA_V((t)+1,sl_next);} \
    CMASK(C0,C1,t); \
    { float a=MX3(C0[0],C0[1],C1[0]),b=MX3(C0[2],C0[3],C1[1]); a=MX3(a,C1[2],C1[3]); \
      _Pragma("unroll") for(int r=4;r<16;r+=4){a=MX3(a,C0[r],C0[r+1]);b=MX3(b,C0[r+2],C0[r+3]);a=MX3(a,C1[r],C1[r+1]);b=MX3(b,C1[r+2],C1[r+3]);} \
      float rm=__builtin_fmaxf(a,b); { auto rr=__builtin_amdgcn_permlane32_swap(__float_as_uint(rm),__float_as_uint(rm),false,false); rm=__builtin_fmaxf(__uint_as_float(rr[0]),__uint_as_float(rr[1])); } \
      resc=false; \
      if(__builtin_expect(__any(rm>(float)THRL),0)){ const float dl=__builtin_fmaxf(rm,0.f); mhat+=dl; \
        _Pragma("unroll") for(int r=0;r<16;++r){C0[r]-=dl;C1[r]-=dl;} \
        const float f=__builtin_amdgcn_exp2f(-dl); l_reg*=f; if(hi==0)wsf[r32]=f; resc=true; } } \
    SBAR(); \
    GAPB(o[0]=__builtin_amdgcn_mfma_f32_32x32x16_bf16(PAF(0),VFR(0),o[0],0,0,0), C0,0); \
    GAPB(o[1]=__builtin_amdgcn_mfma_f32_32x32x16_bf16(PAF(0),VFR(4),o[1],0,0,0), C0,4); \
    KRD(GL,0); GAPB(o[0]=__builtin_amdgcn_mfma_f32_32x32x16_bf16(PAF(1),VFR(1),o[0],0,0,0), C0,8); \
    KRD(GL,1); GAPB(o[1]=__builtin_amdgcn_mfma_f32_32x32x16_bf16(PAF(1),VFR(5),o[1],0,0,0), C0,12); \
    KRD(GL,2); GAPB(o[0]=__builtin_amdgcn_mfma_f32_32x32x16_bf16(PAF(2),VFR(2),o[0],0,0,0), C1,0); \
    KRD(GL,3); GAPB(o[1]=__builtin_amdgcn_mfma_f32_32x32x16_bf16(PAF(2),VFR(6),o[1],0,0,0), C1,4); \
    GAPB(o[0]=__builtin_amdgcn_mfma_f32_32x32x16_bf16(PAF(3),VFR(3),o[0],0,0,0), C1,8); \
    GAPB(o[1]=__builtin_amdgcn_mfma_f32_32x32x16_bf16(PAF(3),VFR(7),o[1],0,0,0), C1,12); \
    }while(0)
  int t=1;
  #undef CMASK
  #define CMASK(P0,P1,t) do{}while(0)
  for(;t+5<NT;t+=2){
    STEP(pB0,pB1,pA0,pA1,t,true,true,true);     WAIT_BAR(2); RESC(); ROT();
    STEP(pA0,pA1,pB0,pB1,t+1,true,true,true);   WAIT_BAR(2); RESC(); ROT();
  }
  #undef CMASK
  #define CMASK(P0,P1,t) do{int jb_=(t)-(NT-4); if(jb_>=0)cmask(P0,P1,jb_,qrel,hi);}while(0)
  #define ENDW(tt) do{ if((tt)+3<NT){WAIT_BAR(2);} else if((tt)+2<NT){WAIT_BAR(1);} else {WAIT_BAR(0);} }while(0)
  for(;t+1<NT;t+=2){
    STEP(pB0,pB1,pA0,pA1,t,(t+3<NT),(t+1<NT),(t+1<NT));       ENDW(t);   RESC(); ROT();
    STEP(pA0,pA1,pB0,pB1,t+1,(t+4<NT),(t+2<NT),(t+2<NT));     ENDW(t+1); RESC(); ROT();
  }
  STEP(pB0,pB1,pA0,pA1,NT-1,false,false,false); RESC();
  { float sacc=pB0[0]+pB0[1]; _Pragma("unroll") for(int r=2;r<16;++r)sacc+=pB0[r]; _Pragma("unroll") for(int r=0;r<16;++r)sacc+=pB1[r]; l_reg+=sacc;
    pw0=(u32x4){PKW(pB0,0),PKW(pB0,2),PKW(pB0,4),PKW(pB0,6)};pw1=(u32x4){PKW(pB0,8),PKW(pB0,10),PKW(pB0,12),PKW(pB0,14)};pw2=(u32x4){PKW(pB1,0),PKW(pB1,2),PKW(pB1,4),PKW(pB1,6)};pw3=(u32x4){PKW(pB1,8),PKW(pB1,10),PKW(pB1,12),PKW(pB1,14)};
    SBAR(); pv(o,vb0+sl_cur,PAF(0),PAF(1),PAF(2),PAF(3)); }
  #undef PKW
  #undef PAF
  #undef VFR
  #undef PIN
  #undef MX3
  #undef GAPA
  #undef GAPB
  #undef EX
  #undef VRD
  #undef KRD
  #undef STEP
  #undef ENDW
  {auto rr=__builtin_amdgcn_permlane32_swap(__float_as_uint(l_reg),__float_as_uint(l_reg),false,false);l_reg=__uint_as_float(rr[0])+__uint_as_float(rr[1]);}
  if(hi==0)wsf[32+r32]=l_reg;asm volatile("s_waitcnt lgkmcnt(0)":::"memory");
  float rli[16];
  #pragma unroll
  for(int r=0;r<16;++r)rli[r]=__builtin_amdgcn_rcpf(wsf[32+crow(r,hi)]);
  bf16*Ow=O+(rowbase+q0+wid*QBLK)*DM+h*D;
  { bf16*stg=(bf16*)(shm+LDS_OST)+wid*2048;
    #pragma unroll
    for(int r=0;r<16;++r){const int orow=crow(r,hi);
      #pragma unroll
      for(int d0=0;d0<2;++d0)stg[orow*64+d0*32+r32]=__float2bfloat16(o[d0][r]*rli[r]);}
    asm volatile("s_waitcnt lgkmcnt(0)":::"memory");
    #pragma unroll
    for(int i=0;i<4;++i){const int row=i*8+(lane>>3),ch=lane&7; const u32x4 v=*(const u32x4*)(stg+row*64+ch*8); ATTN_STORE16(Ow+(long)row*DM+ch*8,v);} }
  asm volatile("s_waitcnt lgkmcnt(0)\n\ts_barrier":::"memory");
  #undef DMA_K
  #undef DMA_V
  #undef CMASK
  #undef INITC
  #undef START
  #undef RESC
  #undef ROT
}
constexpr int ATTN_LDS_BYTES=LDS_BYTES;
struct AttnTensors { const bf16* Q; const bf16* K; const bf16* V; bf16* O; };
struct AttnUnit { int bh; int qb; };
#undef SBAR
#undef WAIT_BAR
}

constexpr int SA_STRIDE = 1056;
constexpr size_t WS_SA_PM = WS_HG, WS_SA_PO = WS_HG + 1 * MiB;
typedef float f32x4u __attribute__((ext_vector_type(4), aligned(4)));
struct SaBlk { f32x4 k[2][2][2]; f32x4 v[2][4]; };
__device__ __forceinline__ void sa_load(SaBlk& B, const float* kbase, const float* vbase, int n16, int g) {
#pragma unroll
    for (int tau = 0; tau < 2; ++tau)
#pragma unroll
        for (int ks = 0; ks < 2; ++ks) { const float* p = kbase + (size_t)(16 * tau + n16) * 512 + 32 * ks + 8 * g;
            B.k[tau][ks][0] = __builtin_nontemporal_load((const f32x4*)p); B.k[tau][ks][1] = __builtin_nontemporal_load((const f32x4*)(p + 4)); }
#pragma unroll
    for (int tau = 0; tau < 2; ++tau)
#pragma unroll
        for (int e = 0; e < 4; ++e) B.v[tau][e] = __builtin_nontemporal_load((const f32x4*)(vbase + (size_t)(16 * tau + 4 * g + e) * 512 + 4 * n16));
}
__device__ __forceinline__ bf16x8 pk8(float a, float b, float c, float d, float e, float f, float g, float h) {
    u32x4_t w; w.x = pg8::cvt_pk_bf16(a, b); w.y = pg8::cvt_pk_bf16(c, d); w.z = pg8::cvt_pk_bf16(e, f); w.w = pg8::cvt_pk_bf16(g, h); return __builtin_bit_cast(bf16x8, w); }
struct SaState { float m, l; f32x4 o[4]; };
template <bool NEWBLK> __device__ __forceinline__ void sa_compute(SaState& S, const SaBlk& B, const bf16x8 (&qf)[2], const LAS float* biasp  , int n16, int g) {
    f32x4 x[2];
#pragma unroll
    for (int tau = 0; tau < (NEWBLK ? 1 : 2); ++tau) {
        f32x4 acc = (f32x4){0.f, 0.f, 0.f, 0.f};
#pragma unroll
        for (int ks = 0; ks < 2; ++ks) { const f32x4 lo = B.k[tau][ks][0], hi = B.k[tau][ks][1];
            acc = __builtin_amdgcn_mfma_f32_16x16x32_bf16(pk8(lo[0], lo[1], lo[2], lo[3], hi[0], hi[1], hi[2], hi[3]), qf[ks], acc, 0, 0, 0); }
        const f32x4 bb = *(const LAS f32x4*)(biasp + 16 * tau + 4 * g);
        x[tau] = acc + bb;
    }
    if (NEWBLK) {
#pragma unroll
        for (int i = 0; i < 4; ++i) { const int j = 4 * g + i; if (j > n16 || j >= TS) x[0][i] = -INFINITY; }
        x[1] = (f32x4){-INFINITY, -INFINITY, -INFINITY, -INFINITY};
    }
    const float lm = fmaxf(fmaxf(fmaxf(x[0][0], x[0][1]), fmaxf(x[0][2], x[0][3])), fmaxf(fmaxf(x[1][0], x[1][1]), fmaxf(x[1][2], x[1][3])));
    if (__any(lm > S.m + 8.0f)) {
        float rm = fmaxf(lm, __shfl_xor(lm, 16)); rm = fmaxf(rm, __shfl_xor(rm, 32));
        const float mn = fmaxf(S.m, rm), f = (S.m == -INFINITY) ? 0.f : __builtin_amdgcn_exp2f(S.m - mn);
        S.l *= f;
#pragma unroll
        for (int dt = 0; dt < 4; ++dt) S.o[dt] = S.o[dt] * f;
        S.m = mn;
    }
    float p[2][4];
#pragma unroll
    for (int tau = 0; tau < 2; ++tau)
#pragma unroll
        for (int i = 0; i < 4; ++i) { p[tau][i] = __builtin_amdgcn_exp2f(x[tau][i] - S.m); S.l += p[tau][i]; }
    const bf16x8 pf = pk8(p[0][0], p[0][1], p[0][2], p[0][3], p[1][0], p[1][1], p[1][2], p[1][3]);
#pragma unroll
    for (int dt = 0; dt < 4; ++dt) {
        const bf16x8 vf = NEWBLK ? pk8(B.v[0][0][dt], B.v[0][1][dt], B.v[0][2][dt], B.v[0][3][dt], 0.f, 0.f, 0.f, 0.f)
                                 : pk8(B.v[0][0][dt], B.v[0][1][dt], B.v[0][2][dt], B.v[0][3][dt], B.v[1][0][dt], B.v[1][1][dt], B.v[1][2][dt], B.v[1][3][dt]);
        S.o[dt] = __builtin_amdgcn_mfma_f32_16x16x32_bf16(vf, pf, S.o[dt], 0, 0, 0);
    }
}
__device__ __forceinline__ void sample_attn_unit(Frame& F, int b, int half) {
    const int lane = F.lane, h = F.wave, n16 = lane & 15, g = lane >> 4;
    LAS float* biasL = (LAS float*)(F.lds + RING_OFF) + h * SA_STRIDE;
    {
        const int s0 = 32 * lane; const int pg = F.pt[b * NPG + (s0 >> 7)]; const float* lp = F.clf + ((size_t)pg * PAGE + (s0 & 127)) * FH + h;
        float v[32];
#pragma unroll
        for (int i = 0; i < 32; ++i) v[i] = lp[(size_t)i * FH];
        float tot = 0.f;
#pragma unroll
        for (int i = 31; i >= 0; --i) { const float t = v[i]; v[i] = tot; tot += t; }
        float suf = tot;
#pragma unroll
        for (int o = 1; o < 64; o <<= 1) { const float y = __shfl_down(suf, o); if (lane + o < 64) suf += y; }
        const float after = suf - tot;
        if ((lane >> 5) == half) {
#pragma unroll
            for (int i = 0; i < 32; i += 4) *(LAS f32x4*)(biasL + 32 * (lane & 31) + i) = (f32x4){(v[i] + after) * LOG2E, (v[i + 1] + after) * LOG2E, (v[i + 2] + after) * LOG2E, (v[i + 3] + after) * LOG2E};
        }
        if (half == 1) {
            const float* ln = F.out + O_LFS + (size_t)(b * TS) * FH + h; float acc = 0.f, mine = 0.f;
#pragma unroll
            for (int j = 0; j < TS; ++j) { acc += ln[(size_t)j * FH]; if (lane == j) mine = -acc * LOG2E; }
            if (lane < 16) biasL[1024 + lane] = mine;
        }
        if (lane < 8) ((LAS int*)(biasL + 1040))[lane] = F.pt[b * NPG + 8 * half + lane];
    }
    bf16x8 qf[2];
#pragma unroll
    for (int ks = 0; ks < 2; ++ks) { qf[ks] = (bf16x8){0, 0, 0, 0, 0, 0, 0, 0}; if (n16 < TS) qf[ks] = *(const bf16x8*)(F.QF + (size_t)(MP + b * TS + n16) * FW + h * FD + 32 * ks + 8 * g); }
    SaState S; S.m = -INFINITY; S.l = 0.f;
#pragma unroll
    for (int dt = 0; dt < 4; ++dt) S.o[dt] = (f32x4){0.f, 0.f, 0.f, 0.f};
    LDS_WAIT();
    SaBlk A, Bb;
    if (half == 1) {
        const float* kb = F.out + O_KS + (size_t)(b * TS) * FW + h * FD; const float* vb = F.out + O_VS + (size_t)(b * TS) * FW + h * FD;
#pragma unroll
        for (int ks = 0; ks < 2; ++ks) { const float* p = kb + (size_t)(n16 < TS ? n16 : TS - 1) * 512 + 32 * ks + 8 * g; A.k[0][ks][0] = *(const f32x4*)p; A.k[0][ks][1] = *(const f32x4*)(p + 4); A.k[1][ks][0] = A.k[0][ks][0]; A.k[1][ks][1] = A.k[0][ks][1]; }
#pragma unroll
        for (int e = 0; e < 4; ++e) { const int j = 4 * g + e; A.v[0][e] = *(const f32x4*)(vb + (size_t)(j < TS ? j : TS - 1) * 512 + 4 * n16); A.v[1][e] = (f32x4){0.f, 0.f, 0.f, 0.f}; }
        sa_compute<true>(S, A, qf, biasL + 1024, n16, g);
    }
    const int sbase = 1024 * half;
#define SA_PTRS(blk, KB, VB) const float *KB, *VB; { const int s_ = sbase + 32 * (blk); const int pg_ = __builtin_amdgcn_readfirstlane(((const LAS int*)(biasL + 1040))[(blk) >> 2]); const size_t r_ = (((size_t)pg_ * PAGE + (s_ & 127)) * FH + h) * FD; KB = F.ck + r_; VB = F.cv + r_; }
    { SA_PTRS(31, k0, v0) sa_load(A, k0, v0, n16, g); }
    for (int blk = 31; blk >= 1; blk -= 2) {
        { SA_PTRS(blk - 1, k1, v1) sa_load(Bb, k1, v1, n16, g); }
        sa_compute<false>(S, A, qf, biasL + 32 * blk, n16, g);
        if (blk >= 2) { SA_PTRS(blk - 2, k2, v2) sa_load(A, k2, v2, n16, g); }
        sa_compute<false>(S, Bb, qf, biasL + 32 * (blk - 1), n16, g);
    }
#undef SA_PTRS
    float l = S.l; l += __shfl_xor(l, 16); l += __shfl_xor(l, 32);
    if (n16 < TS) {
        const size_t row = ((size_t)((b * 2 + half) * FH + h)) * TS + n16;
        float* pm = (float*)(F.ws + WS_SA_PM) + row * 2; float* po = (float*)(F.ws + WS_SA_PO) + row * 64;
        if (g == 0) { pm[0] = S.m; pm[1] = l; }
#pragma unroll
        for (int i = 0; i < 4; ++i) *(f32x4*)(po + 16 * g + 4 * i) = (f32x4){S.o[0][i], S.o[1][i], S.o[2][i], S.o[3][i]};
    }
}
__device__ __forceinline__ void p3_attn_sample(Frame& F) {
    for (int u = F.vcu; u < BS * 2; u += F.G) { sample_attn_unit(F, u >> 1, u & 1); __syncthreads(); }
}
__device__ __forceinline__ void p4_attn_sample_combine(Frame& F) {
    const int NT = F.G * NWAVES * 64;
    for (int i = blockIdx.x * (NWAVES * 64) + F.tid; i < BS * TS * FH * 16; i += NT) {
        const int dq = i & 15, h = (i >> 4) & 7, t = (i >> 7) & 7, b = i >> 10;
        const size_t r0 = ((size_t)((b * 2 + 0) * FH + h)) * TS + t, r1 = ((size_t)((b * 2 + 1) * FH + h)) * TS + t;
        const float* pm = (const float*)(F.ws + WS_SA_PM); const float* po = (const float*)(F.ws + WS_SA_PO);
        const float m0 = pm[r0 * 2], l0 = pm[r0 * 2 + 1], m1 = pm[r1 * 2], l1 = pm[r1 * 2 + 1];
        const float mm = fmaxf(m0, m1), w0 = exp2f(m0 - mm), w1 = exp2f(m1 - mm), inv = 1.0f / (w0 * l0 + w1 * l1);
        const f32x4 o0 = *(const f32x4*)(po + r0 * 64 + 4 * dq), o1 = *(const f32x4*)(po + r1 * 64 + 4 * dq);
        const f32x4 o = (o0 * w0 + o1 * w1) * inv;
        unsigned long long* dst = (unsigned long long*)(F.OF + (size_t)(MP + b * TS + t) * FW + h * FD + 4 * dq);
        *dst = (unsigned long long)pk2(o[0], o[1]) | ((unsigned long long)pk2(o[2], o[3]) << 32);
    }
}

constexpr size_t WS_OLOC = 688 * MiB, WS_QD = 722 * MiB, WS_UL = 739 * MiB, WS_DX = 787 * MiB;
constexpr int HG_QT = 0, HG_KT = 8704, HG_KD = 17408, HG_VT = 27648, HG_AB = 37888, HG_TOT = 40448, HG_DD = 42496, HG_PART = 43008, HG_END = 43008 + 8192;
constexpr int HG_NPU = BP * HH * 8, HG_NSU = BS * HH;
__device__ __forceinline__ int kpos(int k) { return (k & ~31) | (((k >> 2) & 3) << 3) | (((k >> 4) & 1) << 2) | (k & 3); }
typedef unsigned short us8 __attribute__((ext_vector_type(8)));

template <bool SMP> __device__ __forceinline__ void hgrn_local_unit(Frame& F, int u) {
    const int tid = F.tid, lane = F.lane, w = F.wave, g = lane >> 4, n16 = lane & 15, k = tid & 127, rg = tid >> 7;
    int b, h, m0;
    if (!SMP) { const int bh = u >> 3, j = u & 7; b = bh >> 2; h = bh & 3; m0 = b * TP + 256 * j; } else { const int sh = u - HG_NPU; b = sh >> 2; h = sh & 3; m0 = MP + TS * b; }
    constexpr int NCH = SMP ? 1 : 8;
    LAS unsigned char* L = F.lds + RING_OFF;
    LAS bf16* QT = (LAS bf16*)(L + HG_QT); LAS bf16* KT = (LAS bf16*)(L + HG_KT); LAS bf16* KD = (LAS bf16*)(L + HG_KD); LAS bf16* VT = (LAS bf16*)(L + HG_VT); LAS bf16* AB = (LAS bf16*)(L + HG_AB);
    LAS float* TOT = (LAS float*)(L + HG_TOT); LAS float* DD = (LAS float*)(L + HG_DD);
    const bool rowsok = !SMP || rg == 0;
    f32x4 Sacc[8];
#pragma unroll
    for (int i = 0; i < 8; ++i) Sacc[i] = (f32x4){0.f, 0.f, 0.f, 0.f};
    float Bprev = 0.f;
    float ng[8]; bf16 nq[8], nv[8];
    const size_t cb = (size_t)h * HK + k;
#pragma unroll
    for (int i = 0; i < 8; ++i) { ng[i] = 0.f; nq[i] = 0; nv[i] = 0; if (rowsok) { const size_t o = (size_t)(m0 + 8 * rg + i) * HW + cb; ng[i] = F.G2[o]; nq[i] = F.QH[o]; nv[i] = F.VH[o]; } }
    const int kp = kpos(k);
    for (int c = 0; c < NCH; ++c) {
        float gq[8]; bf16 qq[8], vv[8];
#pragma unroll
        for (int i = 0; i < 8; ++i) { gq[i] = ng[i]; qq[i] = nq[i]; vv[i] = nv[i]; }
        if (c + 1 < NCH) {
#pragma unroll
            for (int i = 0; i < 8; ++i) { const size_t o = (size_t)(m0 + 32 * (c + 1) + 8 * rg + i) * HW + cb; ng[i] = F.G2[o]; nq[i] = F.QH[o]; nv[i] = F.VH[o]; }
        }
        float cs[8]; float run = 0.f;
#pragma unroll
        for (int i = 0; i < 8; ++i) { run += gq[i]; cs[i] = run; }
        TOT[rg * 128 + k] = run;
        __syncthreads();
        const float t0 = TOT[k], t1 = TOT[128 + k], t2 = TOT[256 + k], t3 = TOT[384 + k];
        const float pre = (rg > 0 ? t0 : 0.f) + (rg > 1 ? t1 : 0.f) + (rg > 2 ? t2 : 0.f), bl = (t0 + t1) + (t2 + t3);
        const float eprev = __builtin_amdgcn_exp2f(Bprev);
        float kdv[8];
#pragma unroll
        for (int i = 0; i < 8; ++i) {
            const float bi = pre + cs[i], eb = __builtin_amdgcn_exp2f(bi), kk = 1.0f - __builtin_amdgcn_exp2f(gq[i]);
            const float qt = bf2f(qq[i]) * eb, kt = kk * __builtin_amdgcn_exp2f(-bi); kdv[i] = kk * __builtin_amdgcn_exp2f(bl - bi);
            const int r = 8 * rg + i;
            QT[r * 136 + kp] = (bf16)f2bf(qt); KT[r * 136 + kp] = (bf16)f2bf(kt);
            if (rowsok) F.ws_qd[(size_t)(m0 + 32 * c + r) * HW + h * HK + kp] = (bf16)f2bf(qt * eprev);
        }
        { u32x4_t wk; wk.x = pg8::cvt_pk_bf16(kdv[0], kdv[1]); wk.y = pg8::cvt_pk_bf16(kdv[2], kdv[3]); wk.z = pg8::cvt_pk_bf16(kdv[4], kdv[5]); wk.w = pg8::cvt_pk_bf16(kdv[6], kdv[7]);
          *(LAS u32x4_t*)(KD + k * 40 + 8 * rg) = wk;
          u32x4_t wv; wv.x = (unsigned)vv[0] | ((unsigned)vv[1] << 16); wv.y = (unsigned)vv[2] | ((unsigned)vv[3] << 16); wv.z = (unsigned)vv[4] | ((unsigned)vv[5] << 16); wv.w = (unsigned)vv[6] | ((unsigned)vv[7] << 16);
          *(LAS u32x4_t*)(VT + k * 40 + 8 * rg) = wv; }
        if (rg == 0) DD[k] = __builtin_amdgcn_exp2f(bl);
        Bprev += bl;
        __syncthreads();
        if (w < 4) {
            const int tt = w >> 1, ss = w & 1; f32x4 a = (f32x4){0.f, 0.f, 0.f, 0.f};
            if (!(tt == 0 && ss == 1)) {
#pragma unroll
                for (int ks = 0; ks < 4; ++ks) { const bf16x8 af = *(const LAS bf16x8*)(QT + (16 * tt + n16) * 136 + 32 * ks + 8 * g), bfr = *(const LAS bf16x8*)(KT + (16 * ss + n16) * 136 + 32 * ks + 8 * g);
                    a = __builtin_amdgcn_mfma_f32_16x16x32_bf16(af, bfr, a, 0, 0, 0); }
            }
#pragma unroll
            for (int i = 0; i < 4; ++i) { const int t = 16 * tt + 4 * g + i, s = 16 * ss + n16; AB[t * 40 + s] = (bf16)f2bf(s <= t ? a[i] : 0.f); }
        }
        __syncthreads();
        const bf16x8 vfr = *(const LAS bf16x8*)(VT + (16 * w + n16) * 40 + 8 * g);
        bf16x8 sfr[4];
#pragma unroll
        for (int j = 0; j < 4; ++j) sfr[j] = pk8(Sacc[2 * j][0], Sacc[2 * j][1], Sacc[2 * j][2], Sacc[2 * j][3], Sacc[2 * j + 1][0], Sacc[2 * j + 1][1], Sacc[2 * j + 1][2], Sacc[2 * j + 1][3]);
#pragma unroll
        for (int hh = 0; hh < (SMP ? 1 : 2); ++hh) {
            f32x4 acc = (f32x4){0.f, 0.f, 0.f, 0.f};
#pragma unroll
            for (int j = 0; j < 4; ++j) { const bf16x8 qfr = *(const LAS bf16x8*)(QT + (16 * hh + n16) * 136 + 32 * j + 8 * g); acc = __builtin_amdgcn_mfma_f32_16x16x32_bf16(sfr[j], qfr, acc, 0, 0, 0); }
            const bf16x8 abf = *(const LAS bf16x8*)(AB + (16 * hh + n16) * 40 + 8 * g);
            acc = __builtin_amdgcn_mfma_f32_16x16x32_bf16(vfr, abf, acc, 0, 0, 0);
            if (!SMP || n16 < TS) *(f32x4*)(F.ws_oloc + (size_t)(m0 + 32 * c + 16 * hh + n16) * HW + h * HK + 16 * w + 4 * g) = acc;
        }
#pragma unroll
        for (int kt = 0; kt < 8; ++kt) { const bf16x8 kdf = *(const LAS bf16x8*)(KD + (16 * kt + n16) * 40 + 8 * g); const f32x4 d4 = *(const LAS f32x4*)(DD + 16 * kt + 4 * g);
            Sacc[kt] = __builtin_amdgcn_mfma_f32_16x16x32_bf16(kdf, vfr, Sacc[kt] * d4, 0, 0, 0); }
    }
    f32x4* ul = (f32x4*)(F.ws + WS_UL) + ((size_t)(u * 8 + w) * 8) * 64 + lane;
#pragma unroll
    for (int kt = 0; kt < 8; ++kt) ul[kt * 64] = Sacc[kt];
    if (rg == 0) ((float*)(F.ws + WS_DX))[(size_t)u * HK + k] = __builtin_amdgcn_exp2f(Bprev);
    __syncthreads();
}
__device__ __forceinline__ void p3_hgrn_local(Frame& F) {
    for (int u = F.vcu; u < HG_NPU; u += F.G) hgrn_local_unit<false>(F, u);
    for (int u = HG_NPU + F.vcu; u < HG_NPU + HG_NSU; u += F.G) hgrn_local_unit<true>(F, u);
}

template <bool SMP> __device__ __forceinline__ void hgrn_fix_unit(Frame& F, int u) {
    const int lane = F.lane, w = F.wave, g = lane >> 4, n16 = lane & 15;
    int b, h, m0, j = 0;
    if (!SMP) { const int bh = u >> 3; j = u & 7; b = bh >> 2; h = bh & 3; m0 = b * TP + 256 * j; } else { const int sh = u - HG_NPU; b = sh >> 2; h = sh & 3; m0 = MP + TS * b; }
    constexpr int NCH = SMP ? 1 : 8, NHH = SMP ? 1 : 2;
    LAS float* PART = (LAS float*)(F.lds + RING_OFF + HG_PART);
    const float* DX = (const float*)(F.ws + WS_DX); const f32x4* UL = (const f32x4*)(F.ws + WS_UL);
    f32x4 S[8];
    if (!SMP) {
#pragma unroll
        for (int kt = 0; kt < 8; ++kt) S[kt] = (f32x4){0.f, 0.f, 0.f, 0.f};
        for (int jj = 0; jj < j; ++jj) { const int uu = u - j + jj;
#pragma unroll
            for (int kt = 0; kt < 8; ++kt) { const f32x4 dx = *(const f32x4*)(DX + (size_t)uu * HK + 16 * kt + 4 * g); S[kt] = S[kt] * dx + UL[((size_t)(uu * 8 + w) * 8 + kt) * 64 + lane]; } }
    } else {
        const float* sp = F.st0 + ((size_t)(b * HH + h) * HK) * HK + 16 * w + n16;
#pragma unroll
        for (int kt = 0; kt < 8; ++kt)
#pragma unroll
            for (int i = 0; i < 4; ++i) S[kt][i] = sp[(size_t)(16 * kt + 4 * g + i) * HK];
    }
    if (SMP || j == 7) {
        float* so = (SMP ? F.out + O_SS : F.out + O_SP) + ((size_t)(b * HH + h) * HK) * HK + 16 * w + n16;
#pragma unroll
        for (int kt = 0; kt < 8; ++kt) { const f32x4 dx = *(const f32x4*)(DX + (size_t)u * HK + 16 * kt + 4 * g); const f32x4 fin = S[kt] * dx + UL[((size_t)(u * 8 + w) * 8 + kt) * 64 + lane];
#pragma unroll
            for (int i = 0; i < 4; ++i) so[(size_t)(16 * kt + 4 * g + i) * HK] = fin[i]; }
    }
    bf16x8 sfr[4];
#pragma unroll
    for (int q = 0; q < 4; ++q) sfr[q] = pk8(S[2 * q][0], S[2 * q][1], S[2 * q][2], S[2 * q][3], S[2 * q + 1][0], S[2 * q + 1][1], S[2 * q + 1][2], S[2 * q + 1][3]);
    const bool rowok = !SMP || n16 < TS;
    f32x4 o[NCH][NHH];
#pragma unroll
    for (int c = 0; c < NCH; ++c)
#pragma unroll
        for (int hh = 0; hh < NHH; ++hh) {
            const int r = 32 * c + 16 * hh + n16; const size_t ro = (size_t)(m0 + r) * HW + h * HK;
            f32x4 acc = (f32x4){0.f, 0.f, 0.f, 0.f};
#pragma unroll
            for (int q = 0; q < 4; ++q) { bf16x8 qfr = (bf16x8){0, 0, 0, 0, 0, 0, 0, 0}; if (rowok) qfr = *(const bf16x8*)(F.ws_qd + ro + 32 * q + 8 * g); acc = __builtin_amdgcn_mfma_f32_16x16x32_bf16(sfr[q], qfr, acc, 0, 0, 0); }
            f32x4 ol = (f32x4){0.f, 0.f, 0.f, 0.f}; if (rowok) ol = *(const f32x4*)(F.ws_oloc + ro + 16 * w + 4 * g);
            o[c][hh] = ol + acc;
            float ss = (o[c][hh][0] * o[c][hh][0] + o[c][hh][1] * o[c][hh][1]) + (o[c][hh][2] * o[c][hh][2] + o[c][hh][3] * o[c][hh][3]);
            ss += __shfl_xor(ss, 16); ss += __shfl_xor(ss, 32);
            if (g == 0) PART[r * 8 + w] = ss;
        }
    __syncthreads();
    const f32x4 onw = *(const f32x4*)(F.onorm + 16 * w + 4 * g);
#pragma unroll
    for (int c = 0; c < NCH; ++c)
#pragma unroll
        for (int hh = 0; hh < NHH; ++hh) {
            const int r = 32 * c + 16 * hh + n16; const size_t ro = (size_t)(m0 + r) * HW + h * HK + 16 * w + 4 * g;
            const f32x4 p0 = *(const LAS f32x4*)(PART + r * 8), p1 = *(const LAS f32x4*)(PART + r * 8 + 4);
            const float rinv = 1.0f / sqrtf(((p0[0] + p0[1]) + (p0[2] + p0[3]) + (p1[0] + p1[1]) + (p1[2] + p1[3])) * (1.f / HK) + RMS_EPS);
            if (rowok) { const unsigned long long sgw = *(const unsigned long long*)(F.SG + ro);
                const float s0 = __uint_as_float((unsigned)(sgw << 16) ), s1 = __uint_as_float((unsigned)sgw & 0xffff0000u), s2 = __uint_as_float((unsigned)(sgw >> 32) << 16), s3 = __uint_as_float((unsigned)(sgw >> 32) & 0xffff0000u);
                const f32x4 y = o[c][hh] * rinv * onw;
                *(unsigned long long*)(F.OH + ro) = (unsigned long long)pk2(y[0] * s0, y[1] * s1) | ((unsigned long long)pk2(y[2] * s2, y[3] * s3) << 32); }
        }
    __syncthreads();
}
__device__ __forceinline__ void p4_hgrn_fix(Frame& F) {
    for (int u = F.vcu; u < HG_NPU; u += F.G) hgrn_fix_unit<false>(F, u);
    for (int u = HG_NPU + F.vcu; u < HG_NPU + HG_NSU; u += F.G) hgrn_fix_unit<true>(F, u);
}

__device__ __forceinline__ void fox_bias_prompt(Frame& F, int b, int h) {
    const float* lf = F.out + O_LFP + ((size_t)b * TP) * FH + h; const int s0 = 4 * F.tid, lane = F.lane;
    float a0 = lf[(size_t)s0 * FH], a1 = lf[(size_t)(s0 + 1) * FH], a2 = lf[(size_t)(s0 + 2) * FH], a3 = lf[(size_t)(s0 + 3) * FH];
    a1 += a0; a2 += a1; a3 += a2;
    float tot = a3;
#pragma unroll
    for (int o = 1; o < 64; o <<= 1) { const float y = __shfl_up(tot, o); if (lane >= o) tot += y; }
    LAS float* wt = (LAS float*)(F.lds + RING_OFF + attn_body::LDS_WS); LAS float* bias = (LAS float*)(F.lds + RING_OFF + attn_body::LDS_BIAS);
    if (lane == 63) wt[F.wave] = tot;
    __syncthreads();
    float pre = 0.f;
    for (int w = 0; w < F.wave; ++w) pre += wt[w];
    const float ex = pre + tot - a3;
    *(LAS f32x4*)(bias + s0) = (f32x4){-(ex + a0) * LOG2E, -(ex + a1) * LOG2E, -(ex + a2) * LOG2E, -(ex + a3) * LOG2E};
    __syncthreads();
}
__device__ __forceinline__ void p3_attn_prompt(Frame& F) {
    static_assert(attn_body::LDS_BYTES <= RING_BYTES && attn_body::DM == FW && attn_body::SEQ == TP && attn_body::BATCH == BP, "attention body geometry");
    char* shm = F.ldsg + RING_OFF;
    const attn_body::bf16 *Q = (const attn_body::bf16*)F.QF, *K = (const attn_body::bf16*)F.KF, *V = (const attn_body::bf16*)F.VF; attn_body::bf16* O = (attn_body::bf16*)F.OF;
    const int j = F.vcu;
    if (j < BP * FH * 4) {
        const int bh = j >> 2, s = j & 3, b = bh >> 3, h = bh & 7;
        fox_bias_prompt(F, b, h);
        for (int i = 0; i < 2; ++i) attn_body::attn_unit<8>(b, h, i ? s : 7 - s, Q, K, V, O, shm);
    }
}

#ifndef MK_N_LAUNCHES
#define MK_N_LAUNCHES 1
#endif
constexpr int NPHASE = 12;
constexpr int N_LAUNCHES = MK_N_LAUNCHES;
struct Args { const void* in[24]; float* out; unsigned char* ws; int ph_lo, ph_hi, li, pad; };
__global__ void __launch_bounds__(NWAVES * 64, 2) fwd_kernel(Args args) {
    extern __shared__ __attribute__((aligned(16))) unsigned char lds[];
    Frame F;
    F.lds = (LAS unsigned char*)lds; F.ldsg = (char*)lds; F.MISC = (volatile LAS unsigned*)(F.lds + MISC_OFF);
    F.tid = threadIdx.x; F.lane = F.tid & 63; F.wave = __builtin_amdgcn_readfirstlane(F.tid >> 6);
    F.G = gridDim.x; { const int bx = blockIdx.x; F.vcu = (F.G % 8 == 0) ? (bx % 8) * (F.G / 8) + bx / 8 : bx; }
    unsigned char* ws = args.ws; F.ws = ws; F.out = args.out;
    F.ctl = (gu32*)(ws + WS_CTL);
    F.xp = (const float*)args.in[0]; F.xs = (const float*)args.in[1]; F.cp = (const float*)args.in[2]; F.cs = (const float*)args.in[3];
    F.ck = (const float*)args.in[4]; F.cv = (const float*)args.in[5]; F.clf = (const float*)args.in[6]; F.st0 = (const float*)args.in[7]; F.pt = (const int*)args.in[8];
    F.ada_w = (const float*)args.in[9]; F.ada_b = (const float*)args.in[10]; F.n1pre = (const float*)args.in[11]; F.n1post = (const float*)args.in[12];
    F.n2pre = (const float*)args.in[13]; F.n2post = (const float*)args.in[14]; F.w_in = (const float*)args.in[15]; F.lbw = (const float*)args.in[16];
    F.onorm = (const float*)args.in[17]; F.fxb = (const float*)args.in[18]; F.w_brh = (const float*)args.in[19]; F.w_brf = (const float*)args.in[20];
    F.w_out = (const float*)args.in[21]; F.w_up = (const float*)args.in[22]; F.w_dn = (const float*)args.in[23];
    F.MOD = (float*)(ws + WS_MOD); F.Win_t = (bf16*)(ws + WS_WIN); F.Wbh_t = (bf16*)(ws + WS_WBH); F.Wbf_t = (bf16*)(ws + WS_WBF); F.Wout_t = (bf16*)(ws + WS_WOUT);
    F.Wup_t = (bf16*)(ws + WS_WUP); F.Wdn_t = (bf16*)(ws + WS_WDN); F.H = (bf16*)(ws + WS_H); F.QH = (bf16*)(ws + WS_QH); F.VH = (bf16*)(ws + WS_VH); F.SG = (bf16*)(ws + WS_SG);
    F.QF = (bf16*)(ws + WS_QF); F.KF = (bf16*)(ws + WS_KF); F.VF = (bf16*)(ws + WS_VF); F.G2 = (float*)(ws + WS_G2); F.MG = (bf16*)(ws + WS_MG); F.OF = (bf16*)(ws + WS_OF);
    F.OH = (bf16*)(ws + WS_OH); F.T1 = (float*)(ws + WS_T1); F.MRG = (bf16*)(ws + WS_MRG); F.Y = (float*)(ws + WS_Y); F.ACT = (bf16*)(ws + WS_ACT); F.U2 = (float*)(ws + WS_U2); F.ws_qd = (bf16*)(ws + WS_QD); F.ws_oloc = (float*)(ws + WS_OLOC); F.slab_o = (float*)(ws + WS_SLABO); F.slab_d = (float*)(ws + WS_SLABD);
    for (int u = F.tid; u < (LDS_BYTES - LDSCTL_OFF) / 4; u += NWAVES * 64) ((LAS unsigned*)(F.lds + LDSCTL_OFF))[u] = 0u;
    __syncthreads();
    XcdBarrier bar; bar.bar = (unsigned*)(F.ctl + CW_BAR); bar.x = 0; bar.st = nullptr;
    if (N_LAUNCHES == 1) bar = xcd_barrier_post((unsigned*)(F.ctl + CW_BAR), F.MISC + 8);
#define GRID_BAR(seam) do { if (N_LAUNCHES != 1) { if (F.tid == 0) __hip_atomic_store(F.ctl + CW_TMO, 0xBADBA0u | (unsigned)(seam), RLX_AGENT); } else { xcd_barrier(bar); } } while (0)
    const int lo = args.ph_lo, hi = args.ph_hi;
#define IN(k) (lo <= (k) && (k) < hi)
#define BOTH(k) (IN(k) && IN((k) + 1))
    if (IN(0)) { p0_prologue(F); if (BOTH(0)) GRID_BAR(0); }
    if (IN(1)) { p1_norm1(F); if (BOTH(1)) GRID_BAR(1); }
    if (IN(2)) {
        pg8::Gemm g{F.H, F.Win_t, M, NPROJ, DM, DM, nullptr, nullptr}; pg8::StaticOrder S; S.init(M, NPROJ, F.G, (int)blockIdx.x);
        EpiProj E{F.QH, F.VH, F.SG, F.QF, F.KF, F.VF, F.MG, F.G2, F.out, F.lbw};
        pg8::gemm_phase<EpiProj, pg8::StaticOrder, PG8_ALIGN, PG8_SP2>(F.lds + RING_OFF, g, S, E);
        if (BOTH(2)) GRID_BAR(2);
    }
    if (IN(3)) { p3_attn_prompt(F); __syncthreads(); p3_attn_sample(F); __syncthreads(); p3_hgrn_local(F); if (BOTH(3)) GRID_BAR(3); }
    if (IN(4)) { p4_attn_sample_combine(F); p4_hgrn_fix(F); if (BOTH(4)) GRID_BAR(4); }
    if (IN(5)) {
        pg8::Gemm g{F.OH, F.Wbh_t, M, DM, HW, HW, nullptr, nullptr}; pg8::StaticOrder S; S.init(M, DM, F.G, (int)blockIdx.x);
        EpiBrH E{F.MG, F.T1};
        pg8::gemm_phase<EpiBrH, pg8::StaticOrder, PG8_ALIGN, PG8_SP2>(F.lds + RING_OFF, g, S, E);
        if (BOTH(5)) GRID_BAR(5);
    }
    if (IN(6)) {
        pg8::Gemm g{F.OF, F.Wbf_t, M, DM, FW, FW, nullptr, nullptr}; pg8::StaticOrder S; S.init(M, DM, F.G, (int)blockIdx.x);
        EpiBrF E{F.MG, F.T1, F.MRG};
        pg8::gemm_phase<EpiBrF, pg8::StaticOrder, PG8_ALIGN, PG8_SP2>(F.lds + RING_OFF, g, S, E);
        if (BOTH(6)) GRID_BAR(6);
    }
    if (IN(7)) {
        { pg8::Gemm g{F.MRG, F.Wout_t, MP, DM, DM, DM, nullptr, nullptr}; pg8::StaticOrder S; S.init(MP, DM, F.G, (int)blockIdx.x);
          EpiF32 E{F.Y, DM};
          pg8::gemm_phase<EpiF32, pg8::StaticOrder, PG8_ALIGN, PG8_SP2>(F.lds + RING_OFF, g, S, E); }
        { pg8::Gemm g{F.MRG, F.Wout_t, M, DM, DM / 4, DM, nullptr, nullptr}; PieceOrder S{16 * 4, 4, DM / 4, F.G, (int)blockIdx.x, MP / 256, 4};
          EpiSlab E{F.slab_o};
          pg8::gemm_phase<EpiSlab, PieceOrder, PG8_ALIGN, PG8_SP2>(F.lds + RING_OFF, g, S, E); }
        if (BOTH(7)) GRID_BAR(7);
    }
    if (IN(8)) { p8_midnorm(F); if (BOTH(8)) GRID_BAR(8); }
    if (IN(9)) {
        pg8::Gemm g{F.H, F.Wup_t, M, DFF, DM, DM, nullptr, nullptr}; pg8::StaticOrder S; S.init(M, DFF, F.G, (int)blockIdx.x);
        EpiRelu2 E{F.ACT, DFF};
        pg8::gemm_phase<EpiRelu2, pg8::StaticOrder, PG8_ALIGN, PG8_SP2>(F.lds + RING_OFF, g, S, E);
        if (BOTH(9)) GRID_BAR(9);
    }
    if (IN(10)) {
        { pg8::Gemm g{F.ACT, F.Wdn_t, MP, DM, DFF, DFF, nullptr, nullptr}; pg8::StaticOrder S; S.init(MP, DM, F.G, (int)blockIdx.x);
          EpiF32 E{F.U2, DM};
          pg8::gemm_phase<EpiF32, pg8::StaticOrder, PG8_ALIGN, PG8_SP2>(F.lds + RING_OFF, g, S, E); }
        { pg8::Gemm g{F.ACT, F.Wdn_t, M, DM, DFF / 8, DFF, nullptr, nullptr}; PieceOrder S{16 * 8, 8, DFF / 8, F.G, (int)blockIdx.x, MP / 256, 4};
          EpiSlab E{F.slab_d};
          pg8::gemm_phase<EpiSlab, PieceOrder, PG8_ALIGN, PG8_SP2>(F.lds + RING_OFF, g, S, E); }
        if (BOTH(10)) GRID_BAR(10);
    }
    if (IN(11)) { p11_final(F); }
#undef IN
#undef BOTH
}

extern "C" void kernel_launch(void* const* d_in, const int* in_sizes, int n_in, void* d_out, int out_size, void* d_ws, size_t ws_size, hipStream_t stream) {
    static int grid = 0;
    if (grid == 0) {
        if (n_in != 24 || (size_t)out_size != O_END || ws_size < WS_END) { fprintf(stderr, "kernel_launch: unexpected shapes: n_in %d out %d ws %zu (need %zu)\n", n_in, out_size, ws_size, (size_t)WS_END); grid = -1; return; }
        int dev = 0, cus = 0, per_cu = 0;
        if (hipGetDevice(&dev) != hipSuccess || hipDeviceGetAttribute(&cus, hipDeviceAttributeMultiprocessorCount, dev) != hipSuccess) { grid = -1; return; }
        if (hipFuncSetAttribute((const void*)fwd_kernel, hipFuncAttributeMaxDynamicSharedMemorySize, LDS_BYTES) != hipSuccess) { fprintf(stderr, "kernel_launch: hipFuncSetAttribute failed\n"); grid = -1; return; }
        if (hipOccupancyMaxActiveBlocksPerMultiprocessor(&per_cu, (const void*)fwd_kernel, NWAVES * 64, LDS_BYTES) != hipSuccess || per_cu < 1) fprintf(stderr, "kernel_launch: occupancy query reports %d\n", per_cu);
        (void)hipGetLastError();
        grid = cus;
    }
    if (grid < 0) return;
    if (hipMemsetAsync((char*)d_ws + WS_CTL, 0, CTL_ZERO_BYTES, stream) != hipSuccess) return;
    Args a{};
    for (int i = 0; i < 24; ++i) a.in[i] = d_in[i];
    a.out = (float*)d_out; a.ws = (unsigned char*)d_ws;
    if (N_LAUNCHES == 1) { a.ph_lo = 0; a.ph_hi = NPHASE; a.li = 0; hipLaunchKernelGGL(fwd_kernel, dim3(grid), dim3(NWAVES * 64), LDS_BYTES, stream, a); }
    else for (int li = 0; li < NPHASE; ++li) { a.ph_lo = li; a.ph_hi = li + 1; a.li = li; hipLaunchKernelGGL(fwd_kernel, dim3(grid), dim3(NWAVES * 64), LDS_BYTES, stream, a); }
    const hipError_t le = hipPeekAtLastError();
    if (le != hipSuccess) fprintf(stderr, "kernel_launch: launch failed: %s\n", hipGetErrorName(le));
}
```
